# Optimizing an MI355X kernel written in HIP

```python
import functools
import jax, jax.numpy as jnp
from jax import lax
import numpy as np

D_MODEL = 1024
BATCH = 16
SEQ = 2048
DEPTH = 1
DEC_BATCH = 128
DEC_SEQ = 4
PAST_LEN = 16384
PAGE_SIZE = 128

HEAD_DIM = 64
ATTN_WIDTH = D_MODEL // 2
N_Q_HEADS = ATTN_WIDTH // HEAD_DIM
N_KV_HEADS = N_Q_HEADS // 4
KV_WIDTH = N_KV_HEADS * HEAD_DIM
GQA_GROUP = N_Q_HEADS // N_KV_HEADS
RWKV_WIDTH = D_MODEL - ATTN_WIDTH
N_RWKV_HEADS = RWKV_WIDTH // HEAD_DIM
WINDOW = 128
BLOCK = WINDOW
SCALE = HEAD_DIM ** -0.5
DECAY_LORA = 64
AAA_LORA = 64
GATE_LORA = 128
D_FF = 4 * D_MODEL
RMS_EPS = 1e-6
GN_EPS = 64e-5
Q_OFF = 0
K_OFF = Q_OFF + ATTN_WIDTH
V_OFF = K_OFF + KV_WIDTH
RWKV_OFF = V_OFF + KV_WIDTH
RWKV_PROJ = 3 * RWKV_WIDTH + DECAY_LORA + AAA_LORA + GATE_LORA
RWKV_SPLITS = (RWKV_WIDTH, RWKV_WIDTH + DECAY_LORA, 2 * RWKV_WIDTH + DECAY_LORA,
               3 * RWKV_WIDTH + DECAY_LORA, 3 * RWKV_WIDTH + DECAY_LORA + AAA_LORA)
IN_WIDTH = RWKV_OFF + RWKV_PROJ

kernel_name = 'hymba_swa_rwkv7_step'


def _rms_norm(x, g):
    x32 = x.astype(jnp.float32)
    y = x32 * lax.rsqrt(jnp.mean(x32 * x32, axis=-1, keepdims=True) + RMS_EPS)
    return (y * g.astype(jnp.float32)).astype(x.dtype)


def _sink_softmax(scores, mask, sinks):
    s = jnp.where(mask, scores.astype(jnp.float32), -jnp.inf)
    sink = sinks.astype(jnp.float32)[..., None, None]
    m = jnp.maximum(jnp.max(s, axis=-1, keepdims=True), sink)
    p = jnp.exp(s - m)
    return p / (jnp.sum(p, axis=-1, keepdims=True) + jnp.exp(sink - m))


def _swa_prompt(q, k, v, sinks):
    B, S = q.shape[0], q.shape[1]
    nb = S // BLOCK
    qb = q.reshape(B, nb, BLOCK, N_KV_HEADS, GQA_GROUP, HEAD_DIM)
    kb = k.reshape(B, nb, BLOCK, N_KV_HEADS, HEAD_DIM)
    vb = v.reshape(B, nb, BLOCK, N_KV_HEADS, HEAD_DIM)

    def with_prev(t):
        prev = jnp.concatenate([jnp.zeros_like(t[:, :1]), t[:, :-1]], axis=1)
        return jnp.concatenate([prev, t], axis=2)

    kc, vc = with_prev(kb), with_prev(vb)
    blk = jnp.arange(nb)[:, None] * BLOCK
    qpos = blk + jnp.arange(BLOCK)[None, :]
    kpos = blk + jnp.arange(2 * BLOCK)[None, :] - BLOCK
    rel = qpos[:, :, None] - kpos[:, None, :]
    mask = (rel >= 0) & (rel < WINDOW) & (kpos[:, None, :] >= 0)
    scores = jnp.einsum('bnqhgd,bnkhd->bnhgqk', qb, kc) * SCALE
    probs = _sink_softmax(scores, mask[None, :, None, None], sinks.reshape(N_KV_HEADS, GQA_GROUP))
    out = jnp.einsum('bnhgqk,bnkhd->bnqhgd', probs.astype(v.dtype), vc)
    return out.reshape(B, S, ATTN_WIDTH), k[:, S - WINDOW:], v[:, S - WINDOW:]


def _swa_cached(cache_k, cache_v, q, k, v, sinks):
    B, T = q.shape[0], q.shape[1]
    wc = cache_k.shape[1]
    kall = jnp.concatenate([cache_k.astype(k.dtype), k], axis=1)
    vall = jnp.concatenate([cache_v.astype(v.dtype), v], axis=1)
    rel = jnp.arange(T)[:, None] - (jnp.arange(wc + T)[None, :] - wc)
    mask = (rel >= 0) & (rel < WINDOW)
    qg = q.reshape(B, T, N_KV_HEADS, GQA_GROUP, HEAD_DIM)
    scores = jnp.einsum('bthgd,bkhd->bhgtk', qg, kall) * SCALE
    probs = _sink_softmax(scores, mask, sinks.reshape(N_KV_HEADS, GQA_GROUP))
    out = jnp.einsum('bhgtk,bkhd->bthgd', probs.astype(v.dtype), vall)
    return out.reshape(B, T, ATTN_WIDTH), kall[:, T:], vall[:, T:]


def _wkv7_scan(r, decay, k, v, a_vec, b_vec, s0):
    def step(s, inp):
        r_t, d_t, k_t, v_t, a_t, b_t = inp
        sa = jnp.einsum('bhij,bhj->bhi', s, a_t)
        s = s * d_t[:, :, None, :] + sa[..., None] * b_t[:, :, None, :] + v_t[..., None] * k_t[:, :, None, :]
        return s, jnp.einsum('bhij,bhj->bhi', s, r_t)

    xs = tuple(jnp.swapaxes(t, 0, 1) for t in (r, decay, k, v, a_vec, b_vec))
    s_final, ys = lax.scan(step, s0.astype(jnp.float32), xs)
    return jnp.swapaxes(ys, 0, 1), s_final


def _rwkv7_mix(p, p_prev, s0, lp):
    B, T = p.shape[0], p.shape[1]
    f = lambda t: t.astype(jnp.float32)
    p = f(p)
    p_shift = jnp.concatenate([f(p_prev)[:, None], p[:, :-1]], axis=1)
    pm = p + (p_shift - p) * f(lp['rwkv_mu'])
    xr, xw, xk, xv, xa, xg = jnp.split(pm, RWKV_SPLITS, axis=-1)
    w_log = -jax.nn.softplus(-(f(lp['w_decay_0']) + jnp.tanh(xw) @ f(lp['w_decay_up']))) - 0.5
    decay = jnp.exp(-jnp.exp(w_log))
    a = jax.nn.sigmoid(f(lp['a_0']) + xa @ f(lp['a_up']))
    g = jax.nn.sigmoid(xg) @ f(lp['g_up'])
    hs = lambda t: t.reshape(B, T, N_RWKV_HEADS, HEAD_DIM)
    kk = hs(xk * f(lp['k_k']))
    kk = kk / jnp.maximum(jnp.sqrt(jnp.sum(kk * kk, axis=-1, keepdims=True)), 1e-12)
    a_h = hs(a)
    k_h = hs(xk * (1.0 + (a - 1.0) * f(lp['k_a'])))
    r_h, v_h = hs(xr), hs(xv)
    y, s = _wkv7_scan(r_h, hs(decay), k_h, v_h, -kk, kk * a_h, s0)
    mu = jnp.mean(y, axis=-1, keepdims=True)
    var = jnp.mean(jnp.square(y - mu), axis=-1, keepdims=True)
    yn = ((y - mu) * lax.rsqrt(var + GN_EPS)).reshape(B, T, RWKV_WIDTH) * f(lp['ln_x_g']) + f(lp['ln_x_b'])
    bonus = jnp.sum(r_h * k_h * f(lp['r_k']), axis=-1, keepdims=True) * v_h
    out = (yn + bonus.reshape(B, T, RWKV_WIDTH)) * g
    return out, s


def _layer(x, attn_fn, shift_prev, s0, lp):
    B, T = x.shape[0], x.shape[1]
    h = _rms_norm(x, lp['norm1_g'])
    proj = h @ lp['w_in']
    q = proj[..., Q_OFF:K_OFF].reshape(B, T, N_Q_HEADS, HEAD_DIM)
    k = proj[..., K_OFF:V_OFF].reshape(B, T, N_KV_HEADS, HEAD_DIM)
    v = proj[..., V_OFF:RWKV_OFF].reshape(B, T, N_KV_HEADS, HEAD_DIM)
    q = _rms_norm(q, lp['q_norm_g'])
    k = _rms_norm(k, lp['k_norm_g'])
    attn_out, new_k, new_v = attn_fn(q, k, v, lp['attn_sinks'])
    p_prev = shift_prev.astype(h.dtype) @ lp['w_in'][:, RWKV_OFF:]
    rwkv_out, s_new = _rwkv7_mix(proj[..., RWKV_OFF:], p_prev, s0, lp)
    mix = jnp.concatenate([attn_out, rwkv_out.astype(x.dtype)], axis=-1)
    x = x + mix @ lp['w_out']
    h2 = _rms_norm(x, lp['norm2_g'])
    x = x + jnp.square(jax.nn.relu(h2 @ lp['w_ff_up'])) @ lp['w_ff_down']
    return x, new_k, new_v, s_new, h[:, -1]


def setup_inputs(seed: int = 0) -> dict:
    key = jax.random.key(seed)
    ks = jax.random.split(key, 32)
    f32 = jnp.float32
    nrm = lambda i, shape, s: jax.random.normal(ks[i], shape, f32) * s
    cache_rows = min(WINDOW, PAST_LEN)
    L = DEPTH
    return {
        'x_prompt': nrm(0, (BATCH, SEQ, D_MODEL), 1.0),
        'x_sample': nrm(1, (DEC_BATCH, DEC_SEQ, D_MODEL), 1.0),
        'cache_k': nrm(2, (L, DEC_BATCH, cache_rows, N_KV_HEADS, HEAD_DIM), 1.0),
        'cache_v': nrm(3, (L, DEC_BATCH, cache_rows, N_KV_HEADS, HEAD_DIM), 1.0),
        'state_wkv': nrm(4, (L, DEC_BATCH, N_RWKV_HEADS, HEAD_DIM, HEAD_DIM), 0.1),
        'state_shift': nrm(5, (L, DEC_BATCH, D_MODEL), 1.0),
        'norm1_g': 1.0 + nrm(6, (L, D_MODEL), 0.02),
        'w_in': nrm(7, (L, D_MODEL, IN_WIDTH), D_MODEL ** -0.5),
        'q_norm_g': 1.0 + nrm(8, (L, HEAD_DIM), 0.02),
        'k_norm_g': 1.0 + nrm(9, (L, HEAD_DIM), 0.02),
        'attn_sinks': nrm(10, (L, N_Q_HEADS), 0.5),
        'rwkv_mu': jax.random.uniform(ks[11], (L, RWKV_PROJ), f32),
        'w_decay_0': jax.random.uniform(ks[12], (L, RWKV_WIDTH), f32, -4.0, 1.0),
        'w_decay_up': nrm(13, (L, DECAY_LORA, RWKV_WIDTH), 0.1),
        'a_0': nrm(14, (L, RWKV_WIDTH), 0.1),
        'a_up': nrm(15, (L, AAA_LORA, RWKV_WIDTH), 0.5 * AAA_LORA ** -0.5),
        'g_up': nrm(16, (L, GATE_LORA, RWKV_WIDTH), GATE_LORA ** -0.5),
        'k_k': 0.85 + nrm(17, (L, RWKV_WIDTH), 0.02),
        'k_a': 1.0 + nrm(18, (L, RWKV_WIDTH), 0.02),
        'r_k': nrm(19, (L, N_RWKV_HEADS, HEAD_DIM), 0.1),
        'ln_x_g': 1.0 + nrm(20, (L, RWKV_WIDTH), 0.02),
        'ln_x_b': nrm(21, (L, RWKV_WIDTH), 0.02),
        'w_out': nrm(22, (L, D_MODEL, D_MODEL), D_MODEL ** -0.5),
        'norm2_g': 1.0 + nrm(23, (L, D_MODEL), 0.02),
        'w_ff_up': nrm(24, (L, D_MODEL, D_FF), D_MODEL ** -0.5),
        'w_ff_down': nrm(25, (L, D_FF, D_MODEL), D_FF ** -0.5),
    }


def reference(x_prompt, x_sample, cache_k, cache_v, state_wkv, state_shift, norm1_g, w_in, q_norm_g,
              k_norm_g, attn_sinks, rwkv_mu, w_decay_0, w_decay_up, a_0, a_up, g_up, k_k, k_a, r_k,
              ln_x_g, ln_x_b, w_out, norm2_g, w_ff_up, w_ff_down):
    yp, ys = x_prompt, x_sample
    pk, pv, pw, psh, sk, sv, sw, ssh = [], [], [], [], [], [], [], []
    for l in range(DEPTH):
        lp = {'norm1_g': norm1_g[l], 'w_in': w_in[l], 'q_norm_g': q_norm_g[l], 'k_norm_g': k_norm_g[l],
              'attn_sinks': attn_sinks[l], 'rwkv_mu': rwkv_mu[l], 'w_decay_0': w_decay_0[l],
              'w_decay_up': w_decay_up[l], 'a_0': a_0[l], 'a_up': a_up[l], 'g_up': g_up[l],
              'k_k': k_k[l], 'k_a': k_a[l], 'r_k': r_k[l], 'ln_x_g': ln_x_g[l], 'ln_x_b': ln_x_b[l],
              'w_out': w_out[l], 'norm2_g': norm2_g[l], 'w_ff_up': w_ff_up[l], 'w_ff_down': w_ff_down[l]}
        bp = yp.shape[0]
        zero_shift = jnp.zeros((bp, D_MODEL), yp.dtype)
        zero_wkv = jnp.zeros((bp, N_RWKV_HEADS, HEAD_DIM, HEAD_DIM), jnp.float32)
        yp, k1, v1, w1, s1 = _layer(yp, _swa_prompt, zero_shift, zero_wkv, lp)
        ys, k2, v2, w2, s2 = _layer(ys, functools.partial(_swa_cached, cache_k[l], cache_v[l]),
                                    state_shift[l], state_wkv[l], lp)
        pk.append(k1); pv.append(v1); pw.append(w1); psh.append(s1)
        sk.append(k2); sv.append(v2); sw.append(w2); ssh.append(s2)
    return (yp, ys, jnp.stack(pk), jnp.stack(pv), jnp.stack(pw), jnp.stack(psh),
            jnp.stack(sk), jnp.stack(sv), jnp.stack(sw), jnp.stack(ssh))
```

```cpp
#include <hip/hip_runtime.h>
#include <hip/hip_cooperative_groups.h>
#include <cstdio>
#include <cstdint>
#include <cmath>
namespace cg = cooperative_groups;
namespace pg8 {
#define PG8_LAS __attribute__((address_space(3)))
typedef unsigned short bf16_t;
typedef short bf16x8 __attribute__((ext_vector_type(8)));
typedef float f32x4 __attribute__((ext_vector_type(4)));
typedef unsigned u32x4 __attribute__((ext_vector_type(4)));
constexpr int BM = 256, BK = 64, HALF = 128, HTB = HALF * BK * 2  , STAGE_BYTES = 8 * HTB, NXCD = 8, WGM = 8;

__host__ __device__ __forceinline__ int lds_byte(int r, int c) { const int st = (r >> 4) * 2 + (c >> 5), rr = r & 15, cc = c & 31, ob = rr * 64 + cc * 2; return st * 1024 + (ob ^ (((ob >> 9) & 1) << 5)); }
__host__ __device__ __forceinline__ void stage_rc(int b, int& R, int& C) { const int st = b / 1024, sb = b % 1024, swz = sb ^ (((sb >> 9) & 1) << 5); R = (st >> 1) * 16 + swz / 64; C = (st & 1) * 32 + (swz % 64) / 2; }
__host__ __device__ __forceinline__ int perm32(int rho) { const int n = rho >> 4, i = rho & 15; return 8 * (i >> 2) + 4 * n + (i & 3); }

struct Unit { int pm, pn; };
struct Gemm { const bf16_t* A; const bf16_t* Bt; int M, N, K; };

struct StaticOrder {
    int nM, nN, nwg, G, c;
    __host__ __device__ void init(int M, int N, int G_, int c_) { nM = M / BM; nN = N / BM; nwg = nM * nN; G = G_; c = c_; }
    __host__ __device__ bool next(int i, Unit& u) const {
        const long L = (long)i * G + c; if (L >= nwg) return false;
        int wgid = (int)L; { const int q = nwg / NXCD, r = nwg % NXCD, xcd = wgid % NXCD, off = wgid / NXCD; wgid = (xcd < r ? xcd * (q + 1) : r * (q + 1) + (xcd - r) * q) + off; }
        const int nig = WGM * nN, gid = wgid / nig, fm = gid * WGM, gsz = (nM - fm) < WGM ? (nM - fm) : WGM;
        u.pm = fm + ((wgid % nig) % gsz); u.pn = (wgid % nig) / gsz; return true;
    }
    __device__ __forceinline__ void a_ready(const Unit&) const {}
    __device__ __forceinline__ void done(const Unit&) const {}
};

__device__ __forceinline__ unsigned cvt_pk_bf16(float lo, float hi) { unsigned r; asm volatile("v_cvt_pk_bf16_f32 %0, %1, %2" : "=v"(r) : "v"(lo), "v"(hi)); return r; }
__device__ __forceinline__ u32x4 pack8(const f32x4 v0, const f32x4 v1) { u32x4 w; w.x = cvt_pk_bf16(v0[0], v0[1]); w.y = cvt_pk_bf16(v0[2], v0[3]); w.z = cvt_pk_bf16(v1[0], v1[1]); w.w = cvt_pk_bf16(v1[2], v1[3]); return w; }

struct EpiProj {
    static constexpr bool PERM = true, AFTER_DRAIN = false;
    bf16_t* QKV; bf16_t* P;
    __device__ __forceinline__ void operator()(const f32x4 (&acc)[2][2][4][2], const Unit& u, int wr, int wc, int fr, int fq) const {
        const int row0 = u.pm * BM + wr * 64 + fr;
        bf16_t* base; int ldc, colt;
        if (u.pn < 3) { base = QKV; ldc = 768; colt = u.pn * BM; } else { base = P; ldc = 1792; colt = (u.pn - 3) * BM; }
        const int col0 = colt + wc * 32 + 8 * fq;
#pragma unroll
        for (int ai = 0; ai < 2; ++ai)
#pragma unroll
            for (int m = 0; m < 4; ++m) { bf16_t* rowp = base + (size_t)(row0 + ai * HALF + m * 16) * ldc + col0;
#pragma unroll
                for (int bj = 0; bj < 2; ++bj) *(u32x4*)(rowp + bj * HALF) = pack8(acc[ai][bj][m][0], acc[ai][bj][m][1]); }
    }
};

struct EpiLora {
    static constexpr bool PERM = true, AFTER_DRAIN = false;
    float* Dd; bf16_t* Aa; bf16_t* Gg; const float* w0; const float* a0;
    __device__ __forceinline__ void operator()(const f32x4 (&acc)[2][2][4][2], const Unit& u, int wr, int wc, int fr, int fq) const {
        const int row0 = u.pm * BM + wr * 64 + fr;
        const int kind = u.pn >> 1;
        const int col0 = (u.pn & 1) * BM + wc * 32 + 8 * fq;
        if (kind == 0) {
            f32x4 bv[2][2];
#pragma unroll
            for (int bj = 0; bj < 2; ++bj)
#pragma unroll
                for (int n = 0; n < 2; ++n) bv[bj][n] = *(const f32x4*)(w0 + col0 + bj * HALF + 4 * n);
#pragma unroll
            for (int ai = 0; ai < 2; ++ai)
#pragma unroll
                for (int m = 0; m < 4; ++m) { float* rp = Dd + (size_t)(row0 + ai * HALF + m * 16) * 512 + col0;
#pragma unroll
                    for (int bj = 0; bj < 2; ++bj)
#pragma unroll
                        for (int n = 0; n < 2; ++n) { f32x4 v = acc[ai][bj][m][n] + bv[bj][n];
                            *(f32x4*)(rp + bj * HALF + 4 * n) = v; } }
        } else if (kind == 1) {
            f32x4 bv[2][2];
#pragma unroll
            for (int bj = 0; bj < 2; ++bj)
#pragma unroll
                for (int n = 0; n < 2; ++n) bv[bj][n] = *(const f32x4*)(a0 + col0 + bj * HALF + 4 * n);
#pragma unroll
            for (int ai = 0; ai < 2; ++ai)
#pragma unroll
                for (int m = 0; m < 4; ++m) { bf16_t* rp = Aa + (size_t)(row0 + ai * HALF + m * 16) * 512 + col0;
#pragma unroll
                    for (int bj = 0; bj < 2; ++bj) { f32x4 v0 = acc[ai][bj][m][0] + bv[bj][0], v1 = acc[ai][bj][m][1] + bv[bj][1];
                        *(u32x4*)(rp + bj * HALF) = pack8(v0, v1); } }
        } else {
#pragma unroll
            for (int ai = 0; ai < 2; ++ai)
#pragma unroll
                for (int m = 0; m < 4; ++m) { bf16_t* rp = Gg + (size_t)(row0 + ai * HALF + m * 16) * 512 + col0;
#pragma unroll
                    for (int bj = 0; bj < 2; ++bj) *(u32x4*)(rp + bj * HALF) = pack8(acc[ai][bj][m][0], acc[ai][bj][m][1]); }
        }
    }
};

struct EpiOut {
    static constexpr bool PERM = true, AFTER_DRAIN = false;
    const float* xp; const float* xs; int TPr; float* out; bf16_t* X1G; const float* g2; float* SSQ;
    __device__ __forceinline__ void operator()(const f32x4 (&acc)[2][2][4][2], const Unit& u, int wr, int wc, int fr, int fq) const {
        const int row0 = u.pm * BM + wr * 64 + fr;
        const int col0 = u.pn * BM + wc * 32 + 8 * fq;
        f32x4 gv[2][2];
#pragma unroll
        for (int bj = 0; bj < 2; ++bj)
#pragma unroll
            for (int n = 0; n < 2; ++n) gv[bj][n] = *(const f32x4*)(g2 + col0 + bj * HALF + 4 * n);
#pragma unroll
        for (int ai = 0; ai < 2; ++ai)
#pragma unroll
            for (int m = 0; m < 4; ++m) { const int row = row0 + ai * HALF + m * 16;
                const float* xr = (row < TPr ? xp + (size_t)row * 1024 : xs + (size_t)(row - TPr) * 1024) + col0;
                float* orow = out + (size_t)row * 1024 + col0; bf16_t* grow = X1G + (size_t)row * 1024 + col0;
                float ss = 0.f;
#pragma unroll
                for (int bj = 0; bj < 2; ++bj) {
                    const f32x4 v0 = acc[ai][bj][m][0] + *(const f32x4*)(xr + bj * HALF), v1 = acc[ai][bj][m][1] + *(const f32x4*)(xr + bj * HALF + 4);
                    *(f32x4*)(orow + bj * HALF) = v0; *(f32x4*)(orow + bj * HALF + 4) = v1;
                    ss += (v0[0] * v0[0] + v0[1] * v0[1]) + (v0[2] * v0[2] + v0[3] * v0[3]) + (v1[0] * v1[0] + v1[1] * v1[1]) + (v1[2] * v1[2] + v1[3] * v1[3]);
                    *(u32x4*)(grow + bj * HALF) = pack8(v0 * gv[bj][0], v1 * gv[bj][1]);
                }
                ss += __shfl_xor(ss, 16); ss += __shfl_xor(ss, 32);
                if (fq == 0) atomicAdd(SSQ + row, ss);
            }
    }
};

struct EpiUp {
    static constexpr bool PERM = true, AFTER_DRAIN = false;
    bf16_t* U; const float* SSQ;
    __device__ __forceinline__ void operator()(const f32x4 (&acc)[2][2][4][2], const Unit& u, int wr, int wc, int fr, int fq) const {
        const int row0 = u.pm * BM + wr * 64 + fr;
        const int col0 = u.pn * BM + wc * 32 + 8 * fq;
#pragma unroll
        for (int ai = 0; ai < 2; ++ai)
#pragma unroll
            for (int m = 0; m < 4; ++m) { const int row = row0 + ai * HALF + m * 16;
                const float rs = rsqrtf(SSQ[row] * (1.0f / 1024.0f) + 1e-6f);
                bf16_t* rowp = U + (size_t)row * 4096 + col0;
#pragma unroll
                for (int bj = 0; bj < 2; ++bj) {
                    f32x4 v0 = acc[ai][bj][m][0] * rs, v1 = acc[ai][bj][m][1] * rs;
#pragma unroll
                    for (int e = 0; e < 4; ++e) { const float a = fmaxf(v0[e], 0.f), b = fmaxf(v1[e], 0.f); v0[e] = a * a; v1[e] = b * b; }
                    *(u32x4*)(rowp + bj * HALF) = pack8(v0, v1);
                } }
    }
};

struct EpiDown {
    static constexpr bool PERM = true, AFTER_DRAIN = false;
    float* out;
    __device__ __forceinline__ void operator()(const f32x4 (&acc)[2][2][4][2], const Unit& u, int wr, int wc, int fr, int fq) const {
        const int row0 = u.pm * BM + wr * 64 + fr;
        const int col0 = u.pn * BM + wc * 32 + 8 * fq;
#pragma unroll
        for (int ai = 0; ai < 2; ++ai)
#pragma unroll
            for (int m = 0; m < 4; ++m) { float* orow = out + (size_t)(row0 + ai * HALF + m * 16) * 1024 + col0;
#pragma unroll
                for (int bj = 0; bj < 2; ++bj) {
                    const f32x4 v0 = acc[ai][bj][m][0] + *(const f32x4*)(orow + bj * HALF), v1 = acc[ai][bj][m][1] + *(const f32x4*)(orow + bj * HALF + 4);
                    *(f32x4*)(orow + bj * HALF) = v0; *(f32x4*)(orow + bj * HALF + 4) = v1;
                } }
    }
};

template <class Epi, class Sched, bool ALIGN_EPI = false, bool SP2 = false>
__device__ __forceinline__ void gemm_phase(PG8_LAS unsigned char* lds, const Gemm g, const Sched& S, const Epi& E) {
    const int tid = threadIdx.x, wid = __builtin_amdgcn_readfirstlane(tid >> 6), lane = tid & 63, wr = wid >> 2, wc = wid & 3, fr = lane & 15, fq = lane >> 4;
    const int K = g.K, nt = K / BK;
    unsigned voffA[2], voffB[2];
#pragma unroll
    for (int i = 0; i < 2; ++i) { int R, C; stage_rc(tid * 16 + i * 8192, R, C); const int Rb = Epi::PERM ? ((R & ~31) + perm32(R & 31)) : R;
        voffA[i] = (unsigned)(R * K + C) * 2u; voffB[i] = (unsigned)(Rb * K + C) * 2u; }
    const size_t kstep = (size_t)(BK * 2);
    const size_t hstep = (size_t)HALF * K * 2;
    const size_t tstep = 2 * hstep;
    const unsigned ldsw = (unsigned)wid * 1024u;
    const int aoff = lds_byte(wr * 64 + fr, fq * 8), boff = lds_byte(wc * 32 + fr, fq * 8);
#define PG8_SA(b, h) (((b) * 2 + (h)) * HTB)
#define PG8_SB(b, h) ((4 + (b) * 2 + (h)) * HTB)
#define PG8_STAGE(bufoff, gbase, voff) do { _Pragma("unroll") for (int _i = 0; _i < 2; ++_i) \
        __builtin_amdgcn_global_load_lds((const unsigned*)((const char*)(gbase) + (voff)[_i]), (PG8_LAS unsigned*)(lds + (bufoff) + ldsw + _i * 8192), 16, 0, 0); } while (0)
#define PG8_LDA(dst, b, h) do { _Pragma("unroll") for (int m = 0; m < 4; ++m) _Pragma("unroll") for (int k = 0; k < 2; ++k) dst[m][k] = *(const PG8_LAS bf16x8*)(lds + PG8_SA(b, h) + aoff + m * 2048 + k * 1024); } while (0)
#define PG8_LDB(dst, b, h) do { _Pragma("unroll") for (int n = 0; n < 2; ++n) _Pragma("unroll") for (int k = 0; k < 2; ++k) dst[n][k] = *(const PG8_LAS bf16x8*)(lds + PG8_SB(b, h) + boff + n * 2048 + k * 1024); } while (0)
#define PG8_MMA(ai, bj, At, Bt) do { __builtin_amdgcn_s_setprio(1); _Pragma("unroll") for (int m = 0; m < 4; ++m) _Pragma("unroll") for (int n = 0; n < 2; ++n) _Pragma("unroll") for (int k = 0; k < 2; ++k) \
        acc[ai][bj][m][n] = __builtin_amdgcn_mfma_f32_16x16x32_bf16(Bt[n][k], At[m][k], acc[ai][bj][m][n], 0, 0, 0); __builtin_amdgcn_s_setprio(0); } while (0)
#define PG8_WAIT_V(n) asm volatile("s_waitcnt vmcnt(" #n ")" ::: "memory")
#define PG8_WAIT_L(n) asm volatile("s_waitcnt lgkmcnt(" #n ")" ::: "memory")
#define PG8_BAR __builtin_amdgcn_s_barrier()
#define PG8_SCHED __builtin_amdgcn_sched_barrier(0)
    Unit cur, nxt; int ui = 0;
    if (!S.next(0, cur)) return;
    f32x4 acc[2][2][4][2];
#pragma unroll
    for (int a = 0; a < 2; ++a)
#pragma unroll
        for (int b = 0; b < 2; ++b)
#pragma unroll
            for (int m = 0; m < 4; ++m)
#pragma unroll
                for (int n = 0; n < 2; ++n) acc[a][b][m][n] = (f32x4){0.f, 0.f, 0.f, 0.f};
    bf16x8 At[4][2], B0[2][2], B1[2][2];
    const char* cA = (const char*)g.A + (size_t)cur.pm * tstep; const char* cB = (const char*)g.Bt + (size_t)cur.pn * tstep;
    S.a_ready(cur);
    if constexpr (SP2) {
        PG8_STAGE(PG8_SB(0, 0), cB, voffB); PG8_STAGE(PG8_SB(0, 1), cB + hstep, voffB); PG8_STAGE(PG8_SA(0, 0), cA, voffA); PG8_STAGE(PG8_SA(0, 1), cA + hstep, voffA);
        if (wr == 1) PG8_BAR;
        PG8_WAIT_V(2); PG8_BAR;
        PG8_STAGE(PG8_SB(1, 0), cB + kstep, voffB); PG8_STAGE(PG8_SA(1, 0), cA + kstep, voffA); PG8_STAGE(PG8_SB(1, 1), cB + hstep + kstep, voffB);
        PG8_WAIT_V(6); PG8_BAR;
    } else {
        PG8_STAGE(PG8_SB(0, 0), cB, voffB); PG8_STAGE(PG8_SA(0, 0), cA, voffA); PG8_STAGE(PG8_SB(0, 1), cB + hstep, voffB); PG8_STAGE(PG8_SA(0, 1), cA + hstep, voffA);
        if (wr == 1) PG8_BAR;
        PG8_WAIT_V(4); PG8_BAR;
        PG8_STAGE(PG8_SB(1, 0), cB + kstep, voffB); PG8_STAGE(PG8_SA(1, 0), cA + kstep, voffA); PG8_STAGE(PG8_SB(1, 1), cB + hstep + kstep, voffB);
        PG8_WAIT_V(6); PG8_BAR;
    }
    for (;;) {
        const bool has_next = S.next(ui + 1, nxt);
        const char* nA = has_next ? (const char*)g.A + (size_t)nxt.pm * tstep : cA; const char* nB = has_next ? (const char*)g.Bt + (size_t)nxt.pn * tstep : cB;
#pragma unroll 1
        for (int t = 0; t < nt; t += 2) {
            const bool last = (t == nt - 2);
            const char* a1 = cA + (size_t)(t + 1) * kstep;
            const char* a2 = last ? nA : cA + (size_t)(t + 2) * kstep; const char* b2 = last ? nB : cB + (size_t)(t + 2) * kstep;
            const char* a3 = a2 + kstep; const char* b3 = b2 + kstep;
            if (last && has_next) S.a_ready(nxt);
            if constexpr (SP2) {
            PG8_LDB(B0, 0, 0); PG8_LDB(B1, 0, 1); PG8_SCHED; PG8_LDA(At, 0, 0); PG8_STAGE(PG8_SA(1, 1), a1 + hstep, voffA);
            PG8_WAIT_V(8); PG8_WAIT_L(0); PG8_BAR; PG8_MMA(0, 0, At, B0); PG8_MMA(0, 1, At, B1); PG8_BAR; PG8_SCHED;
            PG8_LDA(At, 0, 1); PG8_STAGE(PG8_SB(0, 0), b2, voffB); PG8_STAGE(PG8_SB(0, 1), b2 + hstep, voffB); PG8_STAGE(PG8_SA(0, 0), a2, voffA);
            PG8_WAIT_V(8); PG8_WAIT_L(0); PG8_BAR; PG8_MMA(1, 0, At, B0); PG8_MMA(1, 1, At, B1); PG8_BAR; PG8_SCHED;
            PG8_LDB(B0, 1, 0); PG8_LDB(B1, 1, 1); PG8_SCHED; PG8_LDA(At, 1, 0); PG8_STAGE(PG8_SA(0, 1), a2 + hstep, voffA);
            PG8_WAIT_V(8); PG8_WAIT_L(0); PG8_BAR; PG8_MMA(0, 0, At, B0); PG8_MMA(0, 1, At, B1); PG8_BAR; PG8_SCHED;
            PG8_LDA(At, 1, 1); PG8_STAGE(PG8_SB(1, 0), b3, voffB); PG8_STAGE(PG8_SB(1, 1), b3 + hstep, voffB); PG8_STAGE(PG8_SA(1, 0), a3, voffA);
            PG8_WAIT_V(8); PG8_WAIT_L(0); PG8_BAR; PG8_MMA(1, 0, At, B0); PG8_MMA(1, 1, At, B1); PG8_BAR; PG8_SCHED;
            } else {
            PG8_LDB(B0, 0, 0); PG8_SCHED; PG8_LDA(At, 0, 0); PG8_STAGE(PG8_SA(1, 1), a1 + hstep, voffA);
            PG8_WAIT_L(8); PG8_BAR; PG8_WAIT_L(0); PG8_MMA(0, 0, At, B0); PG8_BAR; PG8_SCHED;
            PG8_LDB(B1, 0, 1); PG8_STAGE(PG8_SB(0, 0), b2, voffB);
            PG8_BAR; PG8_WAIT_L(0); PG8_MMA(0, 1, At, B1); PG8_BAR;
            PG8_LDA(At, 0, 1); PG8_STAGE(PG8_SA(0, 0), a2, voffA);
            PG8_BAR; PG8_WAIT_L(0); PG8_MMA(1, 0, At, B0); PG8_BAR; PG8_SCHED;
            PG8_STAGE(PG8_SB(0, 1), b2 + hstep, voffB);
            PG8_WAIT_V(6); PG8_BAR; PG8_MMA(1, 1, At, B1); PG8_BAR;
            PG8_LDB(B0, 1, 0); PG8_SCHED; PG8_LDA(At, 1, 0); PG8_STAGE(PG8_SA(0, 1), a2 + hstep, voffA);
            PG8_WAIT_L(8); PG8_BAR; PG8_WAIT_L(0); PG8_MMA(0, 0, At, B0); PG8_BAR; PG8_SCHED;
            PG8_LDB(B1, 1, 1); PG8_STAGE(PG8_SB(1, 0), b3, voffB);
            PG8_BAR; PG8_WAIT_L(0); PG8_MMA(0, 1, At, B1); PG8_BAR;
            PG8_LDA(At, 1, 1); PG8_STAGE(PG8_SA(1, 0), a3, voffA);
            PG8_BAR; PG8_WAIT_L(0); PG8_MMA(1, 0, At, B0); PG8_BAR; PG8_SCHED;
            PG8_STAGE(PG8_SB(1, 1), b3 + hstep, voffB);
            PG8_WAIT_V(6); PG8_BAR; PG8_MMA(1, 1, At, B1); PG8_BAR;
            }
        }
        if constexpr (ALIGN_EPI) { if (wr == 0) PG8_BAR; }
        if constexpr (!Epi::AFTER_DRAIN) { E(acc, cur, wr, wc, fr, fq); S.done(cur); }
        if (!has_next) break;
#pragma unroll
        for (int a = 0; a < 2; ++a)
#pragma unroll
            for (int b = 0; b < 2; ++b)
#pragma unroll
                for (int m = 0; m < 4; ++m)
#pragma unroll
                    for (int n = 0; n < 2; ++n) acc[a][b][m][n] = (f32x4){0.f, 0.f, 0.f, 0.f};
        cur = nxt; cA = nA; cB = nB; ++ui;
        if constexpr (ALIGN_EPI) { if (wr == 1) PG8_BAR; }
    }
    PG8_WAIT_V(0);
    if constexpr (!ALIGN_EPI) { if (wr == 0) PG8_BAR; }
    PG8_BAR;
    if constexpr (Epi::AFTER_DRAIN) { E.fused(acc, cur, wr, wc, fr, fq, lds, wid, lane); S.done(cur); }
#undef PG8_SA
#undef PG8_SB
#undef PG8_STAGE
#undef PG8_LDA
#undef PG8_LDB
#undef PG8_MMA
#undef PG8_WAIT_V
#undef PG8_WAIT_L
#undef PG8_BAR
#undef PG8_SCHED
}
}
#define LAS __attribute__((address_space(3)))
typedef unsigned short bf16;
typedef short bf16x8 __attribute__((ext_vector_type(8)));
typedef float f32x4 __attribute__((ext_vector_type(4)));
typedef float f32x16 __attribute__((ext_vector_type(16)));
typedef unsigned u32x4 __attribute__((ext_vector_type(4)));
typedef unsigned u32x2 __attribute__((ext_vector_type(2)));

constexpr int DM = 1024, NB = 16, SEQ = 2048, DB = 128, DT = 4;
constexpr int TP = NB * SEQ, TS = DB * DT, MT = TP + TS, M1 = 33536;
constexpr int RW = 1792, QW = 768;
constexpr int R_OFF = 0, W_OFF = 512, K_OFF = 576, V_OFF = 1088, A_OFF = 1600, G_OFF = 1664;
constexpr float RMS_EPS = 1e-6f, GN_EPS = 64e-5f, QSCALE = 0.125f;

constexpr size_t WS_WIN = 0, WS_WOUT = WS_WIN + (size_t)2560 * 1024 * 2, WS_WUP = WS_WOUT + (size_t)1024 * 1024 * 2, WS_WDN = WS_WUP + (size_t)4096 * 1024 * 2,
                 WS_WL = WS_WDN + (size_t)4096 * 1024 * 2, WS_SSQ = WS_WL + (size_t)1536 * 256 * 2, WS_HN = 25165824,
                 WS_QKV = WS_HN + (size_t)M1 * 1024 * 2, WS_P = WS_QKV + (size_t)M1 * QW * 2, WS_L = WS_P + (size_t)M1 * RW * 2, WS_D = WS_L + (size_t)MT * 256 * 2,
                 WS_A = WS_D + (size_t)MT * 512 * 4, WS_G = WS_A + (size_t)MT * 512 * 2, WS_MIX = WS_G + (size_t)MT * 512 * 2, WS_END = WS_MIX + (size_t)MT * 1024 * 2;
constexpr size_t WS_Y = WS_HN, WS_BON = WS_QKV, WS_X1G = WS_A, WS_U = WS_HN;
static_assert(WS_SSQ + (size_t)MT * 4 <= WS_HN, "ws map");
static_assert(WS_U + (size_t)MT * 4096 * 2 <= WS_A, "U overlay");
static_assert(WS_Y + (size_t)MT * 512 * 4 <= WS_QKV && WS_BON + (size_t)MT * 512 * 2 <= WS_P && WS_X1G + (size_t)MT * 1024 * 2 <= WS_MIX, "overlays");

constexpr size_t O_YP = 0, O_YS = O_YP + (size_t)TP * 1024, O_KP = O_YS + (size_t)TS * 1024, O_VP = O_KP + 262144, O_WP = O_VP + 262144, O_SP = O_WP + 524288,
                 O_KS = O_SP + 16384, O_VS = O_KS + 2097152, O_WS = O_VS + 2097152, O_SS = O_WS + 4194304, O_END = O_SS + 131072;

constexpr int LDS_BYTES = 131072 + 1024;
constexpr int NTHR = 512;

struct Args { const float* in[26]; float* out; unsigned char* ws; int ph_lo, ph_hi; };

__device__ __forceinline__ float bf2f(unsigned short v) { return __uint_as_float((unsigned)v << 16); }
__device__ __forceinline__ float bflo(unsigned v) { return __uint_as_float(v << 16); }
__device__ __forceinline__ float bfhi(unsigned v) { return __uint_as_float(v & 0xffff0000u); }
__device__ __forceinline__ unsigned pk2(float lo, float hi) { return pg8::cvt_pk_bf16(lo, hi); }
__device__ __forceinline__ float wave_sum(float v) {
#pragma unroll
    for (int o = 32; o >= 1; o >>= 1) v += __shfl_xor(v, o);
    return v;
}
__device__ __forceinline__ float wave_max(float v) {
#pragma unroll
    for (int o = 32; o >= 1; o >>= 1) v = fmaxf(v, __shfl_xor(v, o));
    return v;
}
template <int CTRL> __device__ __forceinline__ float dpp_mov(float x) { return __builtin_bit_cast(float, __builtin_amdgcn_update_dpp(0, __builtin_bit_cast(int, x), CTRL, 0xF, 0xF, true)); }
__device__ __forceinline__ float sum16(float x) {
    x += dpp_mov<0xB1>(x);
    x += dpp_mov<0x4E>(x);
    x += dpp_mov<0x124>(x);
    x += dpp_mov<0x128>(x);
    return x;
}

__device__ __forceinline__ void transpose_tile(const float* __restrict__ W, int K, int N, bf16* WT, int kt, int nt, LAS float* scr, int tid) {
#pragma unroll
    for (int i = 0; i < 8; ++i) { const int idx = tid + i * NTHR, kk = idx >> 6, nn = idx & 63; scr[kk * 65 + nn] = W[(size_t)(kt * 64 + kk) * N + nt * 64 + nn]; }
    __syncthreads();
    { const int n = tid >> 3, k8 = (tid & 7) * 8; float v[8];
#pragma unroll
      for (int j = 0; j < 8; ++j) v[j] = scr[(k8 + j) * 65 + n];
      u32x4 w; w.x = pk2(v[0], v[1]); w.y = pk2(v[2], v[3]); w.z = pk2(v[4], v[5]); w.w = pk2(v[6], v[7]);
      *(u32x4*)(WT + (size_t)(nt * 64 + n) * K + kt * 64 + k8) = w; }
    __syncthreads();
}

__device__ __forceinline__ void phase0(const Args& a, LAS unsigned char* lds) {
    const int tid = threadIdx.x, lane = tid & 63, wave = tid >> 6, G = gridDim.x, bx = blockIdx.x;
    unsigned char* ws = a.ws;
    LAS float* scr = (LAS float*)lds;
    for (int it = bx; it < 640 + 256 + 1024 + 1024; it += G) {
        if (it < 640) transpose_tile(a.in[7], 1024, 2560, (bf16*)(ws + WS_WIN), it / 40, it % 40, scr, tid);
        else if (it < 896) { const int j = it - 640; transpose_tile(a.in[22], 1024, 1024, (bf16*)(ws + WS_WOUT), j / 16, j % 16, scr, tid); }
        else if (it < 1920) { const int j = it - 896; transpose_tile(a.in[24], 1024, 4096, (bf16*)(ws + WS_WUP), j / 64, j % 64, scr, tid); }
        else { const int j = it - 1920; transpose_tile(a.in[25], 4096, 1024, (bf16*)(ws + WS_WDN), j / 16, j % 16, scr, tid); }
    }
    { bf16* WL = (bf16*)(ws + WS_WL); const float* wd = a.in[13]; const float* au = a.in[15]; const float* gu = a.in[16];
      for (int idx = bx * NTHR + tid; idx < 1536 * 256; idx += G * NTHR) { const int n = idx >> 8, k = idx & 255; float v = 0.f;
          if (n < 512) { if (k < 64) v = wd[k * 512 + n]; } else if (n < 1024) { if (k >= 64 && k < 128) v = au[(k - 64) * 512 + (n - 512)]; } else { if (k >= 128) v = gu[(k - 128) * 512 + (n - 1024)]; }
          WL[idx] = (bf16)(pk2(v, 0.f) & 0xffffu); } }
    { float* SSQ = (float*)(ws + WS_SSQ); for (int idx = bx * NTHR + tid; idx < MT; idx += G * NTHR) SSQ[idx] = 0.f; }
    { bf16* HN = (bf16*)(ws + WS_HN); const float* g1 = a.in[6];
      f32x4 gv[4];
#pragma unroll
      for (int i = 0; i < 4; ++i) gv[i] = *(const f32x4*)(g1 + lane * 4 + i * 256);
      for (int row = bx * 8 + wave; row < M1; row += G * 8) {
          const float* src = row < TP ? a.in[0] + (size_t)row * 1024 : (row < MT ? a.in[1] + (size_t)(row - TP) * 1024 : (row < MT + DB ? a.in[5] + (size_t)(row - MT) * 1024 : nullptr));
          f32x4 v[4]; float ss = 0.f;
#pragma unroll
          for (int i = 0; i < 4; ++i) { v[i] = src ? *(const f32x4*)(src + lane * 4 + i * 256) : (f32x4){0.f, 0.f, 0.f, 0.f}; ss += (v[i][0] * v[i][0] + v[i][1] * v[i][1]) + (v[i][2] * v[i][2] + v[i][3] * v[i][3]); }
          if (row < MT) { ss = wave_sum(ss); const float rs = rsqrtf(ss * (1.0f / 1024.0f) + RMS_EPS);
#pragma unroll
              for (int i = 0; i < 4; ++i) v[i] = v[i] * rs * gv[i]; }
          float* so = nullptr;
          if (row < TP) { if ((row & (SEQ - 1)) == SEQ - 1) so = a.out + O_SP + (size_t)(row >> 11) * 1024; }
          else if (row < MT) { const int r = row - TP; if ((r & 3) == 3) so = a.out + O_SS + (size_t)(r >> 2) * 1024; }
#pragma unroll
          for (int i = 0; i < 4; ++i) { u32x2 w; w.x = pk2(v[i][0], v[i][1]); w.y = pk2(v[i][2], v[i][3]); *(u32x2*)(HN + (size_t)row * 1024 + lane * 4 + i * 256) = w;
              if (so) *(f32x4*)(so + lane * 4 + i * 256) = v[i]; }
      } }
}

__device__ __forceinline__ int prev_row_of(int row) {
    if (row < TP) return (row & (SEQ - 1)) ? row - 1 : -1;
    const int r = row - TP; return (r & 3) ? row - 1 : MT + (r >> 2);
}
__device__ __forceinline__ void unpack8(const u32x4 w, float* v) { v[0] = bflo(w.x); v[1] = bfhi(w.x); v[2] = bflo(w.y); v[3] = bfhi(w.y); v[4] = bflo(w.z); v[5] = bfhi(w.z); v[6] = bflo(w.w); v[7] = bfhi(w.w); }
__device__ __forceinline__ void phase_lora_in(const Args& a) {
    const bf16* P = (const bf16*)(a.ws + WS_P); bf16* L = (bf16*)(a.ws + WS_L); const float* mu = a.in[11];
    for (int idx = blockIdx.x * NTHR + threadIdx.x; idx < MT * 32; idx += gridDim.x * NTHR) {
        const int row = idx >> 5, c = (idx & 31) * 8;
        const int pc = c < 64 ? W_OFF + c : (c < 128 ? A_OFF + (c - 64) : G_OFF + (c - 128));
        const int pr = prev_row_of(row);
        float p[8], q[8];
        unpack8(*(const u32x4*)(P + (size_t)row * RW + pc), p);
        if (pr >= 0) unpack8(*(const u32x4*)(P + (size_t)pr * RW + pc), q); else {
#pragma unroll
            for (int j = 0; j < 8; ++j) q[j] = 0.f; }
        const f32x4 m0 = *(const f32x4*)(mu + pc), m1 = *(const f32x4*)(mu + pc + 4);
        float o[8];
#pragma unroll
        for (int j = 0; j < 8; ++j) { const float m = j < 4 ? m0[j] : m1[j - 4]; const float x = p[j] + (q[j] - p[j]) * m;
            o[j] = c < 64 ? tanhf(x) : (c < 128 ? x : 1.0f / (1.0f + __expf(-x))); }
        u32x4 w; w.x = pk2(o[0], o[1]); w.y = pk2(o[2], o[3]); w.z = pk2(o[4], o[5]); w.w = pk2(o[6], o[7]);
        *(u32x4*)(L + (size_t)row * 256 + c) = w;
    }
}

constexpr int KROW = 144;
constexpr int VROW = 528;
constexpr int ATT_K = 0, ATT_V = 256 * KROW;
__device__ __forceinline__ int crow(int reg, int h) { return (reg & 3) + 8 * (reg >> 2) + 4 * h; }
#define MFMA32(a, b, c) __builtin_amdgcn_mfma_f32_32x32x16_bf16((a), (b), (c), 0, 0, 0)

__device__ __forceinline__ void attn_prompt_unit(const Args& a, LAS unsigned char* lds, int unit) {
    const int tid = threadIdx.x, lane = tid & 63, wave = tid >> 6;
    const int kvh = unit & 1, n = (unit >> 1) & 15, b = unit >> 5;
    const bf16* QKV = (const bf16*)(a.ws + WS_QKV); bf16* MIX = (bf16*)(a.ws + WS_MIX);
    const float* kg = a.in[9]; const float* qg = a.in[8];
    { const int jj = tid >> 1, hf = tid & 1; const int t = n * 128 - 128 + jj;
      float kx[32], vx[32];
      if (t >= 0) { const bf16* src = QKV + (size_t)(b * SEQ + t) * QW + 512 + kvh * 64 + hf * 32;
#pragma unroll
          for (int i = 0; i < 4; ++i) { unpack8(*(const u32x4*)(src + i * 8), kx + i * 8); unpack8(*(const u32x4*)(src + 128 + i * 8), vx + i * 8); } }
      else {
#pragma unroll
          for (int i = 0; i < 32; ++i) { kx[i] = 0.f; vx[i] = 0.f; } }
      float ss = 0.f;
#pragma unroll
      for (int i = 0; i < 32; ++i) ss += kx[i] * kx[i];
      ss += __shfl_xor(ss, 1);
      const float rs = rsqrtf(ss * (1.0f / 64.0f) + RMS_EPS);
#pragma unroll
      for (int i = 0; i < 32; ++i) kx[i] = kx[i] * rs * kg[hf * 32 + i];
#pragma unroll
      for (int i = 0; i < 4; ++i) { u32x4 w; w.x = pk2(kx[i * 8], kx[i * 8 + 1]); w.y = pk2(kx[i * 8 + 2], kx[i * 8 + 3]); w.z = pk2(kx[i * 8 + 4], kx[i * 8 + 5]); w.w = pk2(kx[i * 8 + 6], kx[i * 8 + 7]);
          *(LAS u32x4*)(lds + ATT_K + jj * KROW + hf * 64 + i * 16) = w; }
#pragma unroll
      for (int i = 0; i < 32; ++i) *(LAS bf16*)(lds + ATT_V + (hf * 32 + i) * VROW + jj * 2) = (bf16)(pk2(vx[i], 0.f) & 0xffffu);
      if (n == 15 && jj >= 128) { float* ko = a.out + O_KP + ((size_t)(b * 128 + jj - 128) * 2 + kvh) * 64 + hf * 32; float* vo = a.out + O_VP + ((size_t)(b * 128 + jj - 128) * 2 + kvh) * 64 + hf * 32;
#pragma unroll
          for (int i = 0; i < 8; ++i) { *(f32x4*)(ko + i * 4) = (f32x4){kx[i * 4], kx[i * 4 + 1], kx[i * 4 + 2], kx[i * 4 + 3]}; *(f32x4*)(vo + i * 4) = (f32x4){vx[i * 4], vx[i * 4 + 1], vx[i * 4 + 2], vx[i * 4 + 3]}; } }
    }
    __syncthreads();
    const int r = lane & 31, h = lane >> 5;
#pragma unroll 1
    for (int it = 0; it < 2; ++it) {
        const int su = wave + 8 * it, g = su >> 2, q0 = (su & 3) * 32, head = kvh * 4 + g;
        const int tok = b * SEQ + n * 128 + q0 + r;
        bf16x8 qb[4];
        { float qx[32]; const bf16* src = QKV + (size_t)tok * QW + head * 64 + 8 * h;
#pragma unroll
          for (int ds = 0; ds < 4; ++ds) unpack8(*(const u32x4*)(src + ds * 16), qx + ds * 8);
          float ss = 0.f;
#pragma unroll
          for (int i = 0; i < 32; ++i) ss += qx[i] * qx[i];
          ss += __shfl_xor(ss, 32);
          const float rs = rsqrtf(ss * (1.0f / 64.0f) + RMS_EPS) * QSCALE;
#pragma unroll
          for (int ds = 0; ds < 4; ++ds) { u32x4 w; const float* gq = qg + ds * 16 + 8 * h; const float* x = qx + ds * 8;
              w.x = pk2(x[0] * rs * gq[0], x[1] * rs * gq[1]); w.y = pk2(x[2] * rs * gq[2], x[3] * rs * gq[3]); w.z = pk2(x[4] * rs * gq[4], x[5] * rs * gq[5]); w.w = pk2(x[6] * rs * gq[6], x[7] * rs * gq[7]);
              qb[ds] = __builtin_bit_cast(bf16x8, w); } }
        f32x16 x[5];
#pragma unroll
        for (int kt = 0; kt < 5; ++kt) {
#pragma unroll
            for (int i = 0; i < 16; ++i) x[kt][i] = 0.f;
#pragma unroll
            for (int ds = 0; ds < 4; ++ds) { const bf16x8 ka = *(const LAS bf16x8*)(lds + ATT_K + (q0 + kt * 32 + r) * KROW + (ds * 16 + 8 * h) * 2); x[kt] = MFMA32(ka, qb[ds], x[kt]); } }
        const float sink = a.in[10][head];
        float m = sink;
#pragma unroll
        for (int kt = 0; kt < 5; ++kt)
#pragma unroll
            for (int i = 0; i < 16; ++i) { const int jr = kt * 32 + crow(i, h); const int rel = jr - r; const bool ok = rel > 0 && rel <= 128 && (n > 0 || q0 + jr >= 128);
                x[kt][i] = ok ? x[kt][i] : -INFINITY; m = fmaxf(m, x[kt][i]); }
        m = fmaxf(m, __shfl_xor(m, 32));
        float sum = 0.f;
#pragma unroll
        for (int kt = 0; kt < 5; ++kt)
#pragma unroll
            for (int i = 0; i < 16; ++i) { x[kt][i] = __expf(x[kt][i] - m); sum += x[kt][i]; }
        sum += __shfl_xor(sum, 32);
        const float inv = 1.0f / (sum + __expf(sink - m));
        f32x16 y[2];
#pragma unroll
        for (int dt = 0; dt < 2; ++dt)
#pragma unroll
            for (int i = 0; i < 16; ++i) y[dt][i] = 0.f;
#pragma unroll
        for (int kt = 0; kt < 5; ++kt)
#pragma unroll
            for (int s = 0; s < 2; ++s) { u32x4 pw; pw.x = pk2(x[kt][8 * s], x[kt][8 * s + 1]); pw.y = pk2(x[kt][8 * s + 2], x[kt][8 * s + 3]); pw.z = pk2(x[kt][8 * s + 4], x[kt][8 * s + 5]); pw.w = pk2(x[kt][8 * s + 6], x[kt][8 * s + 7]);
                const bf16x8 ps = __builtin_bit_cast(bf16x8, pw);
#pragma unroll
                for (int dt = 0; dt < 2; ++dt) { const LAS unsigned char* vp = lds + ATT_V + (dt * 32 + r) * VROW + (q0 + kt * 32 + 16 * s + 4 * h) * 2;
                    const u32x2 lo = *(const LAS u32x2*)vp, hi = *(const LAS u32x2*)(vp + 16); u32x4 vw; vw.x = lo.x; vw.y = lo.y; vw.z = hi.x; vw.w = hi.y;
                    y[dt] = MFMA32(__builtin_bit_cast(bf16x8, vw), ps, y[dt]); } }
        bf16* orow = MIX + (size_t)tok * 1024 + head * 64;
#pragma unroll
        for (int dt = 0; dt < 2; ++dt)
#pragma unroll
            for (int gq = 0; gq < 4; ++gq) { u32x2 w; w.x = pk2(y[dt][4 * gq] * inv, y[dt][4 * gq + 1] * inv); w.y = pk2(y[dt][4 * gq + 2] * inv, y[dt][4 * gq + 3] * inv);
                *(u32x2*)(orow + dt * 32 + 8 * gq + 4 * h) = w; }
    }
    __syncthreads();
}

__device__ __forceinline__ void attn_sample_unit(const Args& a, LAS unsigned char* lds, int unit) {
    const int tid = threadIdx.x, lane = tid & 63, wave = tid >> 6;
    const int kvh = unit & 1, b = unit >> 1;
    const bf16* QKV = (const bf16*)(a.ws + WS_QKV); bf16* MIX = (bf16*)(a.ws + WS_MIX);
    LAS float* Kf = (LAS float*)lds;
    LAS float* Vf = Kf + 132 * 65;
    LAS float* Qf = Vf + 132 * 64;
    LAS float* Pf = Qf + 16 * 64;
    const float* ck = a.in[2]; const float* cv = a.in[3];
    for (int idx = tid; idx < 128 * 64; idx += NTHR) { const int jj = idx >> 6, d = idx & 63; const size_t go = ((size_t)(b * 128 + jj) * 2 + kvh) * 64 + d; Kf[jj * 65 + d] = ck[go]; Vf[jj * 64 + d] = cv[go]; }
    if (wave < 4) { const int t = wave; const bf16* src = QKV + (size_t)(TP + b * 4 + t) * QW + 512 + kvh * 64;
        const float kx = bf2f(src[lane]), vx = bf2f(src[128 + lane]); const float ss = wave_sum(kx * kx);
        Kf[(128 + t) * 65 + lane] = kx * rsqrtf(ss * (1.0f / 64.0f) + RMS_EPS) * a.in[9][lane]; Vf[(128 + t) * 64 + lane] = vx; }
#pragma unroll
    for (int i = 0; i < 2; ++i) { const int row = wave * 2 + i, g = row >> 2, t = row & 3; const bf16* src = QKV + (size_t)(TP + b * 4 + t) * QW + (kvh * 4 + g) * 64;
        const float qx = bf2f(src[lane]); const float ss = wave_sum(qx * qx); Qf[row * 64 + lane] = qx * rsqrtf(ss * (1.0f / 64.0f) + RMS_EPS) * a.in[8][lane] * QSCALE; }
    __syncthreads();
    for (int idx = tid; idx < 128 * 64; idx += NTHR) { const int jj = idx >> 6, d = idx & 63; const size_t go = ((size_t)(b * 128 + jj) * 2 + kvh) * 64 + d; a.out[O_KS + go] = Kf[(jj + 4) * 65 + d]; a.out[O_VS + go] = Vf[(jj + 4) * 64 + d]; }
    for (int idx = tid; idx < 16 * 132; idx += NTHR) { const int row = idx / 132, j = idx - row * 132, t = row & 3; float s = -INFINITY;
        if (j > t && j <= t + 128) { s = 0.f;
#pragma unroll 8
            for (int d = 0; d < 64; ++d) s += Qf[row * 64 + d] * Kf[j * 65 + d]; }
        Pf[row * 136 + j] = s; }
    __syncthreads();
#pragma unroll
    for (int i = 0; i < 2; ++i) { const int row = wave * 2 + i, g = row >> 2; const float sink = a.in[10][kvh * 4 + g];
        float s0 = Pf[row * 136 + lane], s1 = Pf[row * 136 + 64 + lane], s2 = lane < 4 ? Pf[row * 136 + 128 + lane] : -INFINITY;
        float m = wave_max(fmaxf(fmaxf(s0, s1), s2)); m = fmaxf(m, sink);
        s0 = __expf(s0 - m); s1 = __expf(s1 - m); s2 = __expf(s2 - m);
        const float inv = 1.0f / (wave_sum(s0 + s1 + s2) + __expf(sink - m));
        Pf[row * 136 + lane] = s0 * inv; Pf[row * 136 + 64 + lane] = s1 * inv; if (lane < 4) Pf[row * 136 + 128 + lane] = s2 * inv; }
    __syncthreads();
#pragma unroll
    for (int i = 0; i < 2; ++i) { const int idx = tid + i * NTHR, row = idx >> 6, d = idx & 63, g = row >> 2, t = row & 3; float o = 0.f;
        for (int j = 0; j < 132; ++j) o += Pf[row * 136 + j] * Vf[j * 64 + d];
        MIX[(size_t)(TP + b * 4 + t) * 1024 + (kvh * 4 + g) * 64 + d] = (bf16)(pk2(o, 0.f) & 0xffffu); }
    __syncthreads();
}

constexpr int SC_TOK = 32, SC_BUF = 6 * SC_TOK * 64 * 4;
struct ScanRaw { u32x2 pr, qr, pk, qk, pv, qv, aa; f32x4 dd; };
__device__ __forceinline__ f32x4 unpack4(const u32x2 w) { return (f32x4){bflo(w.x), bfhi(w.x), bflo(w.y), bfhi(w.y)}; }

__device__ __forceinline__ void scan_unit(const Args& a, LAS unsigned char* lds, int row0, int T, int prev0, const float* s_in, float* s_out, int h, int half) {
    const int tid = threadIdx.x, rl = tid >> 4, cl = tid & 15, i = half * 32 + rl, j0 = cl * 4;
    const bf16* P = (const bf16*)(a.ws + WS_P); const bf16* Aa = (const bf16*)(a.ws + WS_A); const float* Dd = (const float*)(a.ws + WS_D);
    float* Y = (float*)(a.ws + WS_Y); bf16* BON = (bf16*)(a.ws + WS_BON);
    const int ch = h * 64 + j0;
    const f32x4 mu_r = *(const f32x4*)(a.in[11] + R_OFF + ch), mu_k = *(const f32x4*)(a.in[11] + K_OFF + ch), mu_v = *(const f32x4*)(a.in[11] + V_OFF + ch);
    const f32x4 kkw = *(const f32x4*)(a.in[17] + ch), kaw = *(const f32x4*)(a.in[18] + ch), rkw = *(const f32x4*)(a.in[19] + ch);
    f32x4 s = s_in ? *(const f32x4*)(s_in + i * 64 + j0) : (f32x4){0.f, 0.f, 0.f, 0.f};
    const int nch = (T + SC_TOK - 1) / SC_TOK;
    const int tt = rl;
    ScanRaw raw;
#define SC_LOAD(c) do { const int t_ = (c) * SC_TOK + tt; if (t_ < T) { const int row_ = row0 + t_; const int pr_ = t_ == 0 ? prev0 : row_ - 1; \
        const bf16* p_ = P + (size_t)row_ * RW + ch; raw.pr = *(const u32x2*)(p_ + R_OFF); raw.pk = *(const u32x2*)(p_ + K_OFF); raw.pv = *(const u32x2*)(p_ + V_OFF); \
        if (pr_ >= 0) { const bf16* q_ = P + (size_t)pr_ * RW + ch; raw.qr = *(const u32x2*)(q_ + R_OFF); raw.qk = *(const u32x2*)(q_ + K_OFF); raw.qv = *(const u32x2*)(q_ + V_OFF); } \
        else { raw.qr = (u32x2){0u, 0u}; raw.qk = (u32x2){0u, 0u}; raw.qv = (u32x2){0u, 0u}; } \
        raw.aa = *(const u32x2*)(Aa + (size_t)row_ * 512 + ch); raw.dd = *(const f32x4*)(Dd + (size_t)row_ * 512 + ch); } } while (0)
#define SC_STAGE(c) do { const int t_ = (c) * SC_TOK + tt; if (t_ < T) { const int row_ = row0 + t_; LAS float* B_ = (LAS float*)(lds + ((c) & 1) * SC_BUF) + tt * 64 + j0; \
        f32x4 xr = unpack4(raw.pr), xk = unpack4(raw.pk), xv = unpack4(raw.pv); f32x4 av_ = unpack4(raw.aa); f32x4 dv_ = raw.dd; \
        _Pragma("unroll") for (int e_ = 0; e_ < 4; ++e_) { av_[e_] = 1.0f / (1.0f + __expf(-av_[e_])); dv_[e_] = __expf(-0.60653066f / (1.0f + __expf(-dv_[e_]))); } \
        xr = xr + (unpack4(raw.qr) - xr) * mu_r; xk = xk + (unpack4(raw.qk) - xk) * mu_k; xv = xv + (unpack4(raw.qv) - xv) * mu_v; \
        f32x4 kk = xk * kkw; float ss_ = sum16((kk[0] * kk[0] + kk[1] * kk[1]) + (kk[2] * kk[2] + kk[3] * kk[3])); \
        kk = kk * (1.0f / fmaxf(sqrtf(ss_), 1e-12f)); \
        const f32x4 kh = xk * (1.0f + (av_ - 1.0f) * kaw); \
        const f32x4 rk_ = xr * kh * rkw; const float bs_ = sum16((rk_[0] + rk_[1]) + (rk_[2] + rk_[3])); \
        if ((cl >> 3) == half) { const f32x4 bo = xv * bs_; u32x2 w_; w_.x = pk2(bo[0], bo[1]); w_.y = pk2(bo[2], bo[3]); *(u32x2*)(BON + (size_t)row_ * 512 + ch) = w_; } \
        *(LAS f32x4*)(B_) = -kk; *(LAS f32x4*)(B_ + SC_TOK * 64) = kk * av_; *(LAS f32x4*)(B_ + 2 * SC_TOK * 64) = dv_; \
        *(LAS f32x4*)(B_ + 3 * SC_TOK * 64) = kh; *(LAS f32x4*)(B_ + 4 * SC_TOK * 64) = xr; *(LAS f32x4*)(B_ + 5 * SC_TOK * 64) = xv; } } while (0)
    SC_LOAD(0); SC_STAGE(0);
    __syncthreads();
#pragma unroll 1
    for (int c = 0; c < nch; ++c) {
        if (c + 1 < nch) SC_LOAD(c + 1);
        const LAS float* B = (const LAS float*)(lds + (c & 1) * SC_BUF);
        const int nt = min(SC_TOK, T - c * SC_TOK);
        float* yp = Y + (size_t)(row0 + c * SC_TOK) * 512 + h * 64 + i;
#pragma unroll 4
        for (int t = 0; t < nt; ++t) {
            const f32x4 a4 = *(const LAS f32x4*)(B + t * 64 + j0), b4 = *(const LAS f32x4*)(B + SC_TOK * 64 + t * 64 + j0), d4 = *(const LAS f32x4*)(B + 2 * SC_TOK * 64 + t * 64 + j0),
                        k4 = *(const LAS f32x4*)(B + 3 * SC_TOK * 64 + t * 64 + j0), r4 = *(const LAS f32x4*)(B + 4 * SC_TOK * 64 + t * 64 + j0);
            const float v = B[5 * SC_TOK * 64 + t * 64 + i];
            const float sa = sum16((s[0] * a4[0] + s[1] * a4[1]) + (s[2] * a4[2] + s[3] * a4[3]));
            s = s * d4 + b4 * sa + k4 * v;
            const float y = sum16((s[0] * r4[0] + s[1] * r4[1]) + (s[2] * r4[2] + s[3] * r4[3]));
            if (cl == 0) yp[(size_t)t * 512] = y;
        }
        if (c + 1 < nch) SC_STAGE(c + 1);
        __syncthreads();
    }
    *(f32x4*)(s_out + i * 64 + j0) = s;
#undef SC_LOAD
#undef SC_STAGE
}

__device__ __forceinline__ void phase_post(const Args& a) {
    const float* Y = (const float*)(a.ws + WS_Y); const bf16* BON = (const bf16*)(a.ws + WS_BON); const bf16* Gg = (const bf16*)(a.ws + WS_G); bf16* MIX = (bf16*)(a.ws + WS_MIX);
    for (int idx = blockIdx.x * NTHR + threadIdx.x; idx < MT * 128; idx += gridDim.x * NTHR) {
        const int row = idx >> 7, c = (idx & 127) * 4;
        const f32x4 y = *(const f32x4*)(Y + (size_t)row * 512 + c);
        const float mean = sum16((y[0] + y[1]) + (y[2] + y[3])) * (1.0f / 64.0f);
        const f32x4 dlt = y - mean;
        const float var = sum16((dlt[0] * dlt[0] + dlt[1] * dlt[1]) + (dlt[2] * dlt[2] + dlt[3] * dlt[3])) * (1.0f / 64.0f);
        const f32x4 yn = dlt * rsqrtf(var + GN_EPS) * *(const f32x4*)(a.in[20] + c) + *(const f32x4*)(a.in[21] + c);
        const f32x4 o = (yn + unpack4(*(const u32x2*)(BON + (size_t)row * 512 + c))) * unpack4(*(const u32x2*)(Gg + (size_t)row * 512 + c));
        u32x2 w; w.x = pk2(o[0], o[1]); w.y = pk2(o[2], o[3]);
        *(u32x2*)(MIX + (size_t)row * 1024 + 512 + c) = w;
    }
}

constexpr int N_PHASES = 9;
__global__ void __launch_bounds__(NTHR, 2) hymba_fwd(Args args) {
    extern __shared__ __attribute__((aligned(16))) unsigned char lds_raw[];
    LAS unsigned char* lds = (LAS unsigned char*)lds_raw;
    cg::grid_group grid = cg::this_grid();
    const int G = gridDim.x, bx = blockIdx.x;
    const int vcu = (G % 8 == 0) ? (bx % 8) * (G / 8) + bx / 8 : bx;
    unsigned char* ws = args.ws;
#ifndef PH_MASK
#define PH_MASK 0x1ff
#endif
#define PHON(k) (((PH_MASK >> (k)) & 1) && lo <= (k) && (k) < hi)
#define PHSYNC(k) do { if ((k) + 1 < hi && lo <= (k)) grid.sync(); } while (0)
    const int lo = args.ph_lo, hi = args.ph_hi;
    if (PHON(0)) phase0(args, lds);
    PHSYNC(0);
    if (PHON(1)) { pg8::Gemm g{(const pg8::bf16_t*)(ws + WS_HN), (const pg8::bf16_t*)(ws + WS_WIN), M1, 2560, 1024}; pg8::StaticOrder S; S.init(g.M, g.N, G, bx);
        pg8::EpiProj E{(pg8::bf16_t*)(ws + WS_QKV), (pg8::bf16_t*)(ws + WS_P)}; pg8::gemm_phase<pg8::EpiProj, pg8::StaticOrder, true, true>(lds, g, S, E); }
    PHSYNC(1);
    if (PHON(2)) { phase_lora_in(args);
        for (int u = bx; u < 512; u += G) attn_prompt_unit(args, lds, u);
        for (int u = bx; u < 256; u += G) attn_sample_unit(args, lds, u); }
    PHSYNC(2);
    if (PHON(3)) { pg8::Gemm g{(const pg8::bf16_t*)(ws + WS_L), (const pg8::bf16_t*)(ws + WS_WL), MT, 1536, 256}; pg8::StaticOrder S; S.init(g.M, g.N, G, bx);
        pg8::EpiLora E{(float*)(ws + WS_D), (pg8::bf16_t*)(ws + WS_A), (pg8::bf16_t*)(ws + WS_G), args.in[12], args.in[14]}; pg8::gemm_phase<pg8::EpiLora, pg8::StaticOrder, true, true>(lds, g, S, E); }
    PHSYNC(3);
    if (PHON(4)) {
        for (int u = bx; u < 256; u += G) { const int half = u & 1, h = (u >> 1) & 7, b = u >> 4; scan_unit(args, lds, b * SEQ, SEQ, -1, nullptr, args.out + O_WP + (size_t)(b * 8 + h) * 4096, h, half); }
        for (int u = bx; u < 2048; u += G) { const int half = u & 1, h = (u >> 1) & 7, b = u >> 4; scan_unit(args, lds, TP + b * 4, DT, MT + b, args.in[4] + (size_t)(b * 8 + h) * 4096, args.out + O_WS + (size_t)(b * 8 + h) * 4096, h, half); } }
    PHSYNC(4);
    if (PHON(5)) phase_post(args);
    PHSYNC(5);
    if (PHON(6)) { pg8::Gemm g{(const pg8::bf16_t*)(ws + WS_MIX), (const pg8::bf16_t*)(ws + WS_WOUT), MT, 1024, 1024}; pg8::StaticOrder S; S.init(g.M, g.N, G, bx);
        pg8::EpiOut E{args.in[0], args.in[1], TP, args.out, (pg8::bf16_t*)(ws + WS_X1G), args.in[23], (float*)(ws + WS_SSQ)}; pg8::gemm_phase<pg8::EpiOut, pg8::StaticOrder, true, true>(lds, g, S, E); }
    PHSYNC(6);
    if (PHON(7)) { pg8::Gemm g{(const pg8::bf16_t*)(ws + WS_X1G), (const pg8::bf16_t*)(ws + WS_WUP), MT, 4096, 1024}; pg8::StaticOrder S; S.init(g.M, g.N, G, bx);
        pg8::EpiUp E{(pg8::bf16_t*)(ws + WS_U), (const float*)(ws + WS_SSQ)}; pg8::gemm_phase<pg8::EpiUp, pg8::StaticOrder, true, true>(lds, g, S, E); }
    PHSYNC(7);
    if (PHON(8)) { pg8::Gemm g{(const pg8::bf16_t*)(ws + WS_U), (const pg8::bf16_t*)(ws + WS_WDN), MT, 1024, 4096}; pg8::StaticOrder S; S.init(g.M, g.N, G, bx);
        pg8::EpiDown E{args.out}; pg8::gemm_phase<pg8::EpiDown, pg8::StaticOrder, true, true>(lds, g, S, E); }
    (void)vcu;
}

#ifndef MK_PER_PHASE
#define MK_PER_PHASE 1
#endif
extern "C" void kernel_launch(void* const* d_in, const int* in_sizes, int n_in, void* d_out, int out_size, void* d_ws, size_t ws_size, hipStream_t stream) {
    static int grid = 0;
    if (grid == 0) {
        if (n_in != 26 || (size_t)out_size != O_END || ws_size < WS_END) { fprintf(stderr, "kernel_launch: unexpected sizes n_in %d out %d ws %zu (need %zu)\n", n_in, out_size, ws_size, (size_t)WS_END); grid = -1; return; }
        int dev = 0, cus = 0, per_cu = 0;
        hipGetDevice(&dev); hipDeviceGetAttribute(&cus, hipDeviceAttributeMultiprocessorCount, dev);
        if (hipFuncSetAttribute((const void*)hymba_fwd, hipFuncAttributeMaxDynamicSharedMemorySize, LDS_BYTES) != hipSuccess) { fprintf(stderr, "kernel_launch: hipFuncSetAttribute failed\n"); grid = -1; return; }
        if (hipOccupancyMaxActiveBlocksPerMultiprocessor(&per_cu, (const void*)hymba_fwd, NTHR, LDS_BYTES) != hipSuccess || per_cu < 1) { fprintf(stderr, "kernel_launch: occupancy query failed (%d)\n", per_cu); per_cu = 1; }
        (void)hipGetLastError();
        grid = cus * (per_cu > 1 ? 1 : per_cu);
        fprintf(stderr, "kernel_launch: cus %d per_cu %d grid %d\n", cus, per_cu, grid);
    }
    if (grid < 0) return;
    Args a{};
    for (int i = 0; i < 26; ++i) a.in[i] = (const float*)d_in[i];
    a.out = (float*)d_out; a.ws = (unsigned char*)d_ws;
#if MK_PER_PHASE
    for (int ph = 0; ph < N_PHASES; ++ph) { a.ph_lo = ph; a.ph_hi = ph + 1; hipLaunchKernelGGL(hymba_fwd, dim3(grid), dim3(NTHR), LDS_BYTES, stream, a); }
#else
    a.ph_lo = 0; a.ph_hi = N_PHASES;
    void* kargs[] = {&a};
    hipError_t e = hipLaunchCooperativeKernel((const void*)hymba_fwd, dim3(grid), dim3(NTHR), kargs, LDS_BYTES, stream);
    if (e != hipSuccess) fprintf(stderr, "kernel_launch: cooperative launch failed: %s (grid %d)\n", hipGetErrorString(e), grid);
#endif
}
```

```cpp
#include <hip/hip_runtime.h>
#include <hip/hip_cooperative_groups.h>
#include <cstdio>
#include <cstdint>
#include <cmath>
namespace cg = cooperative_groups;
namespace pg8 {
#define PG8_LAS __attribute__((address_space(3)))
typedef unsigned short bf16_t;
typedef short bf16x8 __attribute__((ext_vector_type(8)));
typedef float f32x4 __attribute__((ext_vector_type(4)));
typedef unsigned u32x4 __attribute__((ext_vector_type(4)));
constexpr int BM = 256, BK = 64, HALF = 128, HTB = HALF * BK * 2  , STAGE_BYTES = 8 * HTB, NXCD = 8, WGM = 8;

__host__ __device__ __forceinline__ int lds_byte(int r, int c) { const int st = (r >> 4) * 2 + (c >> 5), rr = r & 15, cc = c & 31, ob = rr * 64 + cc * 2; return st * 1024 + (ob ^ (((ob >> 9) & 1) << 5)); }
__host__ __device__ __forceinline__ void stage_rc(int b, int& R, int& C) { const int st = b / 1024, sb = b % 1024, swz = sb ^ (((sb >> 9) & 1) << 5); R = (st >> 1) * 16 + swz / 64; C = (st & 1) * 32 + (swz % 64) / 2; }
__host__ __device__ __forceinline__ int perm32(int rho) { const int n = rho >> 4, i = rho & 15; return 8 * (i >> 2) + 4 * n + (i & 3); }

struct Unit { int pm, pn, kb; };
struct Gemm { const bf16_t* A; const bf16_t* Bt; int M, N, K, kloop; };

struct StaticOrder {
    int nM, nN, nwg, G, c;
    __host__ __device__ void init(int M, int N, int G_, int c_) { nM = M / BM; nN = N / BM; nwg = nM * nN; G = G_; c = c_; }
    __host__ __device__ bool next(int i, Unit& u) const {
        const long L = (long)i * G + c; if (L >= nwg) return false;
        int wgid = (int)L; { const int q = nwg / NXCD, r = nwg % NXCD, xcd = wgid % NXCD, off = wgid / NXCD; wgid = (xcd < r ? xcd * (q + 1) : r * (q + 1) + (xcd - r) * q) + off; }
        const int nig = WGM * nN, gid = wgid / nig, fm = gid * WGM, gsz = (nM - fm) < WGM ? (nM - fm) : WGM;
        u.pm = fm + ((wgid % nig) % gsz); u.pn = (wgid % nig) / gsz; u.kb = 0; return true;
    }
    __device__ __forceinline__ void a_ready(const Unit&) const {}
    __device__ __forceinline__ void done(const Unit&) const {}
};
struct SplitKOrder {
    int nM, nN, nK, nwg, G, c, kbytes;
    __host__ __device__ void init(int M, int N, int K, int kloop, int G_, int c_) { nM = M / BM; nN = N / BM; nK = K / kloop; nwg = nM * nN * nK; G = G_; c = c_; kbytes = kloop * 2; }
    __host__ __device__ bool next(int i, Unit& u) const {
        const long L = (long)i * G + c; if (L >= nwg) return false;
        const int kc = (int)L % nK, rest = (int)L / nK; u.pn = rest % nN; u.pm = rest / nN; u.kb = kc * kbytes; return true;
    }
    __device__ __forceinline__ void a_ready(const Unit&) const {}
    __device__ __forceinline__ void done(const Unit&) const {}
};

__device__ __forceinline__ unsigned cvt_pk_bf16(float lo, float hi) { unsigned r; asm volatile("v_cvt_pk_bf16_f32 %0, %1, %2" : "=v"(r) : "v"(lo), "v"(hi)); return r; }
__device__ __forceinline__ u32x4 pack8(const f32x4 v0, const f32x4 v1) { u32x4 w; w.x = cvt_pk_bf16(v0[0], v0[1]); w.y = cvt_pk_bf16(v0[2], v0[3]); w.z = cvt_pk_bf16(v1[0], v1[1]); w.w = cvt_pk_bf16(v1[2], v1[3]); return w; }

struct EpiProj {
    static constexpr bool PERM = true, AFTER_DRAIN = false;
    bf16_t* QKV; bf16_t* P;
    __device__ __forceinline__ void operator()(const f32x4 (&acc)[2][2][4][2], const Unit& u, int wr, int wc, int fr, int fq) const {
        const int row0 = u.pm * BM + wr * 64 + fr;
        bf16_t* base; int ldc, colt;
        if (u.pn < 3) { base = QKV; ldc = 768; colt = u.pn * BM; } else { base = P; ldc = 1792; colt = (u.pn - 3) * BM; }
        const int col0 = colt + wc * 32 + 8 * fq;
#pragma unroll
        for (int ai = 0; ai < 2; ++ai)
#pragma unroll
            for (int m = 0; m < 4; ++m) { bf16_t* rowp = base + (size_t)(row0 + ai * HALF + m * 16) * ldc + col0;
#pragma unroll
                for (int bj = 0; bj < 2; ++bj) *(u32x4*)(rowp + bj * HALF) = pack8(acc[ai][bj][m][0], acc[ai][bj][m][1]); }
    }
};

struct EpiLora {
    static constexpr bool PERM = true, AFTER_DRAIN = false;
    float* Dd; bf16_t* Aa; bf16_t* Gg; const float* w0; const float* a0;
    __device__ __forceinline__ void operator()(const f32x4 (&acc)[2][2][4][2], const Unit& u, int wr, int wc, int fr, int fq) const {
        const int row0 = u.pm * BM + wr * 64 + fr;
        const int kind = u.pn >> 1;
        const int col0 = (u.pn & 1) * BM + wc * 32 + 8 * fq;
        if (kind == 0) {
            f32x4 bv[2][2];
#pragma unroll
            for (int bj = 0; bj < 2; ++bj)
#pragma unroll
                for (int n = 0; n < 2; ++n) bv[bj][n] = *(const f32x4*)(w0 + col0 + bj * HALF + 4 * n);
#pragma unroll
            for (int ai = 0; ai < 2; ++ai)
#pragma unroll
                for (int m = 0; m < 4; ++m) { float* rp = Dd + (size_t)(row0 + ai * HALF + m * 16) * 512 + col0;
#pragma unroll
                    for (int bj = 0; bj < 2; ++bj)
#pragma unroll
                        for (int n = 0; n < 2; ++n) { f32x4 v = acc[ai][bj][m][n] + bv[bj][n];
                            *(f32x4*)(rp + bj * HALF + 4 * n) = v; } }
        } else if (kind == 1) {
            f32x4 bv[2][2];
#pragma unroll
            for (int bj = 0; bj < 2; ++bj)
#pragma unroll
                for (int n = 0; n < 2; ++n) bv[bj][n] = *(const f32x4*)(a0 + col0 + bj * HALF + 4 * n);
#pragma unroll
            for (int ai = 0; ai < 2; ++ai)
#pragma unroll
                for (int m = 0; m < 4; ++m) { bf16_t* rp = Aa + (size_t)(row0 + ai * HALF + m * 16) * 512 + col0;
#pragma unroll
                    for (int bj = 0; bj < 2; ++bj) { f32x4 v0 = acc[ai][bj][m][0] + bv[bj][0], v1 = acc[ai][bj][m][1] + bv[bj][1];
                        *(u32x4*)(rp + bj * HALF) = pack8(v0, v1); } }
        } else {
#pragma unroll
            for (int ai = 0; ai < 2; ++ai)
#pragma unroll
                for (int m = 0; m < 4; ++m) { bf16_t* rp = Gg + (size_t)(row0 + ai * HALF + m * 16) * 512 + col0;
#pragma unroll
                    for (int bj = 0; bj < 2; ++bj) *(u32x4*)(rp + bj * HALF) = pack8(acc[ai][bj][m][0], acc[ai][bj][m][1]); }
        }
    }
};

struct EpiOut {
    static constexpr bool PERM = true, AFTER_DRAIN = false;
    const float* xp; const float* xs; int TPr; float* out; bf16_t* X1G; const float* g2; float* SSQ;
    __device__ __forceinline__ void operator()(const f32x4 (&acc)[2][2][4][2], const Unit& u, int wr, int wc, int fr, int fq) const {
        const int row0 = u.pm * BM + wr * 64 + fr;
        const int col0 = u.pn * BM + wc * 32 + 8 * fq;
        f32x4 gv[2][2];
#pragma unroll
        for (int bj = 0; bj < 2; ++bj)
#pragma unroll
            for (int n = 0; n < 2; ++n) gv[bj][n] = *(const f32x4*)(g2 + col0 + bj * HALF + 4 * n);
#pragma unroll
        for (int ai = 0; ai < 2; ++ai)
#pragma unroll
            for (int m = 0; m < 4; ++m) { const int row = row0 + ai * HALF + m * 16;
                const float* xr = (row < TPr ? xp + (size_t)row * 1024 : xs + (size_t)(row - TPr) * 1024) + col0;
                float* orow = out + (size_t)row * 1024 + col0; bf16_t* grow = X1G + (size_t)row * 1024 + col0;
                float ss = 0.f;
#pragma unroll
                for (int bj = 0; bj < 2; ++bj) {
                    const f32x4 v0 = acc[ai][bj][m][0] + *(const f32x4*)(xr + bj * HALF), v1 = acc[ai][bj][m][1] + *(const f32x4*)(xr + bj * HALF + 4);
                    *(f32x4*)(orow + bj * HALF) = v0; *(f32x4*)(orow + bj * HALF + 4) = v1;
                    ss += (v0[0] * v0[0] + v0[1] * v0[1]) + (v0[2] * v0[2] + v0[3] * v0[3]) + (v1[0] * v1[0] + v1[1] * v1[1]) + (v1[2] * v1[2] + v1[3] * v1[3]);
                    *(u32x4*)(grow + bj * HALF) = pack8(v0 * gv[bj][0], v1 * gv[bj][1]);
                }
                ss += __shfl_xor(ss, 16); ss += __shfl_xor(ss, 32);
                if (fq == 0) atomicAdd(SSQ + row, ss);
            }
    }
};

struct EpiUp {
    static constexpr bool PERM = true, AFTER_DRAIN = false;
    bf16_t* U; const float* SSQ;
    __device__ __forceinline__ void operator()(const f32x4 (&acc)[2][2][4][2], const Unit& u, int wr, int wc, int fr, int fq) const {
        const int row0 = u.pm * BM + wr * 64 + fr;
        const int col0 = u.pn * BM + wc * 32 + 8 * fq;
#pragma unroll
        for (int ai = 0; ai < 2; ++ai)
#pragma unroll
            for (int m = 0; m < 4; ++m) { const int row = row0 + ai * HALF + m * 16;
                const float rs = rsqrtf(SSQ[row] * (1.0f / 1024.0f) + 1e-6f);
                bf16_t* rowp = U + (size_t)row * 4096 + col0;
#pragma unroll
                for (int bj = 0; bj < 2; ++bj) {
                    f32x4 v0 = acc[ai][bj][m][0] * rs, v1 = acc[ai][bj][m][1] * rs;
#pragma unroll
                    for (int e = 0; e < 4; ++e) { const float a = fmaxf(v0[e], 0.f), b = fmaxf(v1[e], 0.f); v0[e] = a * a; v1[e] = b * b; }
                    *(u32x4*)(rowp + bj * HALF) = pack8(v0, v1);
                } }
    }
};

struct EpiDown {
    static constexpr bool PERM = true, AFTER_DRAIN = false;
    float* out;
    __device__ __forceinline__ void operator()(const f32x4 (&acc)[2][2][4][2], const Unit& u, int wr, int wc, int fr, int fq) const {
        const int row0 = u.pm * BM + wr * 64 + fr;
        const int col0 = u.pn * BM + wc * 32 + 8 * fq;
#pragma unroll
        for (int ai = 0; ai < 2; ++ai)
#pragma unroll
            for (int m = 0; m < 4; ++m) { float* orow = out + (size_t)(row0 + ai * HALF + m * 16) * 1024 + col0;
#pragma unroll
                for (int bj = 0; bj < 2; ++bj) {
                    const f32x4 v0 = acc[ai][bj][m][0] + *(const f32x4*)(orow + bj * HALF), v1 = acc[ai][bj][m][1] + *(const f32x4*)(orow + bj * HALF + 4);
                    *(f32x4*)(orow + bj * HALF) = v0; *(f32x4*)(orow + bj * HALF + 4) = v1;
                } }
    }
};

struct EpiDownAtomic {
    static constexpr bool PERM = true, AFTER_DRAIN = false;
    float* out;
    __device__ __forceinline__ void operator()(const f32x4 (&acc)[2][2][4][2], const Unit& u, int wr, int wc, int fr, int fq) const {
        const int row0 = u.pm * BM + wr * 64 + fr;
        const int col0 = u.pn * BM + wc * 32 + 8 * fq;
#pragma unroll
        for (int ai = 0; ai < 2; ++ai)
#pragma unroll
            for (int m = 0; m < 4; ++m) { float* orow = out + (size_t)(row0 + ai * HALF + m * 16) * 1024 + col0;
#pragma unroll
                for (int bj = 0; bj < 2; ++bj)
#pragma unroll
                    for (int n = 0; n < 2; ++n)
#pragma unroll
                        for (int e2 = 0; e2 < 4; ++e2) atomicAdd(orow + bj * HALF + 4 * n + e2, acc[ai][bj][m][n][e2]); }
    }
};

struct EpiPartial {
    static constexpr bool PERM = true, AFTER_DRAIN = false;
    float* part; int mrows, ldc, kbytes;
    __device__ __forceinline__ void operator()(const f32x4 (&acc)[2][2][4][2], const Unit& u, int wr, int wc, int fr, int fq) const {
        const int row0 = u.pm * BM + wr * 64 + fr, col0 = u.pn * BM + wc * 32 + 8 * fq, kc = u.kb / kbytes;
        float* base = part + (size_t)kc * mrows * ldc;
#pragma unroll
        for (int ai = 0; ai < 2; ++ai)
#pragma unroll
            for (int m = 0; m < 4; ++m) { float* orow = base + (size_t)(row0 + ai * HALF + m * 16) * ldc + col0;
#pragma unroll
                for (int bj = 0; bj < 2; ++bj) { *(f32x4*)(orow + bj * HALF) = acc[ai][bj][m][0]; *(f32x4*)(orow + bj * HALF + 4) = acc[ai][bj][m][1]; } }
    }
};

template <class Epi, class Sched, bool ALIGN_EPI = false, bool SP2 = false>
__device__ __forceinline__ void gemm_phase(PG8_LAS unsigned char* lds, const Gemm g, const Sched& S, const Epi& E) {
    const int tid = threadIdx.x, wid = __builtin_amdgcn_readfirstlane(tid >> 6), lane = tid & 63, wr = wid >> 2, wc = wid & 3, fr = lane & 15, fq = lane >> 4;
    const int K = g.K, nt = g.kloop / BK;
    unsigned voffA[2], voffB[2];
#pragma unroll
    for (int i = 0; i < 2; ++i) { int R, C; stage_rc(tid * 16 + i * 8192, R, C); const int Rb = Epi::PERM ? ((R & ~31) + perm32(R & 31)) : R;
        voffA[i] = (unsigned)(R * K + C) * 2u; voffB[i] = (unsigned)(Rb * K + C) * 2u; }
    const size_t kstep = (size_t)(BK * 2);
    const size_t hstep = (size_t)HALF * K * 2;
    const size_t tstep = 2 * hstep;
    const unsigned ldsw = (unsigned)wid * 1024u;
    const int aoff = lds_byte(wr * 64 + fr, fq * 8), boff = lds_byte(wc * 32 + fr, fq * 8);
#define PG8_SA(b, h) (((b) * 2 + (h)) * HTB)
#define PG8_SB(b, h) ((4 + (b) * 2 + (h)) * HTB)
#define PG8_STAGE(bufoff, gbase, voff) do { _Pragma("unroll") for (int _i = 0; _i < 2; ++_i) \
        __builtin_amdgcn_global_load_lds((const unsigned*)((const char*)(gbase) + (voff)[_i]), (PG8_LAS unsigned*)(lds + (bufoff) + ldsw + _i * 8192), 16, 0, 0); } while (0)
#define PG8_LDA(dst, b, h) do { _Pragma("unroll") for (int m = 0; m < 4; ++m) _Pragma("unroll") for (int k = 0; k < 2; ++k) dst[m][k] = *(const PG8_LAS bf16x8*)(lds + PG8_SA(b, h) + aoff + m * 2048 + k * 1024); } while (0)
#define PG8_LDB(dst, b, h) do { _Pragma("unroll") for (int n = 0; n < 2; ++n) _Pragma("unroll") for (int k = 0; k < 2; ++k) dst[n][k] = *(const PG8_LAS bf16x8*)(lds + PG8_SB(b, h) + boff + n * 2048 + k * 1024); } while (0)
#define PG8_MMA(ai, bj, At, Bt) do { __builtin_amdgcn_s_setprio(1); _Pragma("unroll") for (int m = 0; m < 4; ++m) _Pragma("unroll") for (int n = 0; n < 2; ++n) _Pragma("unroll") for (int k = 0; k < 2; ++k) \
        acc[ai][bj][m][n] = __builtin_amdgcn_mfma_f32_16x16x32_bf16(Bt[n][k], At[m][k], acc[ai][bj][m][n], 0, 0, 0); __builtin_amdgcn_s_setprio(0); } while (0)
#define PG8_WAIT_V(n) asm volatile("s_waitcnt vmcnt(" #n ")" ::: "memory")
#define PG8_WAIT_L(n) asm volatile("s_waitcnt lgkmcnt(" #n ")" ::: "memory")
#define PG8_BAR __builtin_amdgcn_s_barrier()
#define PG8_SCHED __builtin_amdgcn_sched_barrier(0)
    Unit cur, nxt; int ui = 0;
    if (!S.next(0, cur)) return;
    f32x4 acc[2][2][4][2];
#pragma unroll
    for (int a = 0; a < 2; ++a)
#pragma unroll
        for (int b = 0; b < 2; ++b)
#pragma unroll
            for (int m = 0; m < 4; ++m)
#pragma unroll
                for (int n = 0; n < 2; ++n) acc[a][b][m][n] = (f32x4){0.f, 0.f, 0.f, 0.f};
    bf16x8 At[4][2], B0[2][2], B1[2][2];
    const char* cA = (const char*)g.A + (size_t)cur.pm * tstep + cur.kb; const char* cB = (const char*)g.Bt + (size_t)cur.pn * tstep + cur.kb;
    S.a_ready(cur);
    if constexpr (SP2) {
        PG8_STAGE(PG8_SB(0, 0), cB, voffB); PG8_STAGE(PG8_SB(0, 1), cB + hstep, voffB); PG8_STAGE(PG8_SA(0, 0), cA, voffA); PG8_STAGE(PG8_SA(0, 1), cA + hstep, voffA);
        if (wr == 1) PG8_BAR;
        PG8_WAIT_V(2); PG8_BAR;
        PG8_STAGE(PG8_SB(1, 0), cB + kstep, voffB); PG8_STAGE(PG8_SA(1, 0), cA + kstep, voffA); PG8_STAGE(PG8_SB(1, 1), cB + hstep + kstep, voffB);
        PG8_WAIT_V(6); PG8_BAR;
    } else {
        PG8_STAGE(PG8_SB(0, 0), cB, voffB); PG8_STAGE(PG8_SA(0, 0), cA, voffA); PG8_STAGE(PG8_SB(0, 1), cB + hstep, voffB); PG8_STAGE(PG8_SA(0, 1), cA + hstep, voffA);
        if (wr == 1) PG8_BAR;
        PG8_WAIT_V(4); PG8_BAR;
        PG8_STAGE(PG8_SB(1, 0), cB + kstep, voffB); PG8_STAGE(PG8_SA(1, 0), cA + kstep, voffA); PG8_STAGE(PG8_SB(1, 1), cB + hstep + kstep, voffB);
        PG8_WAIT_V(6); PG8_BAR;
    }
    for (;;) {
        const bool has_next = S.next(ui + 1, nxt);
        const char* nA = has_next ? (const char*)g.A + (size_t)nxt.pm * tstep + nxt.kb : cA; const char* nB = has_next ? (const char*)g.Bt + (size_t)nxt.pn * tstep + nxt.kb : cB;
#pragma unroll 1
        for (int t = 0; t < nt; t += 2) {
            const bool last = (t == nt - 2);
            const char* a1 = cA + (size_t)(t + 1) * kstep;
            const char* a2 = last ? nA : cA + (size_t)(t + 2) * kstep; const char* b2 = last ? nB : cB + (size_t)(t + 2) * kstep;
            const char* a3 = a2 + kstep; const char* b3 = b2 + kstep;
            if (last && has_next) S.a_ready(nxt);
            if constexpr (SP2) {
            PG8_LDB(B0, 0, 0); PG8_LDB(B1, 0, 1); PG8_SCHED; PG8_LDA(At, 0, 0); PG8_STAGE(PG8_SA(1, 1), a1 + hstep, voffA);
            PG8_WAIT_V(8); PG8_WAIT_L(0); PG8_BAR; PG8_MMA(0, 0, At, B0); PG8_MMA(0, 1, At, B1); PG8_BAR; PG8_SCHED;
            PG8_LDA(At, 0, 1); PG8_STAGE(PG8_SB(0, 0), b2, voffB); PG8_STAGE(PG8_SB(0, 1), b2 + hstep, voffB); PG8_STAGE(PG8_SA(0, 0), a2, voffA);
            PG8_WAIT_V(8); PG8_WAIT_L(0); PG8_BAR; PG8_MMA(1, 0, At, B0); PG8_MMA(1, 1, At, B1); PG8_BAR; PG8_SCHED;
            PG8_LDB(B0, 1, 0); PG8_LDB(B1, 1, 1); PG8_SCHED; PG8_LDA(At, 1, 0); PG8_STAGE(PG8_SA(0, 1), a2 + hstep, voffA);
            PG8_WAIT_V(8); PG8_WAIT_L(0); PG8_BAR; PG8_MMA(0, 0, At, B0); PG8_MMA(0, 1, At, B1); PG8_BAR; PG8_SCHED;
            PG8_LDA(At, 1, 1); PG8_STAGE(PG8_SB(1, 0), b3, voffB); PG8_STAGE(PG8_SB(1, 1), b3 + hstep, voffB); PG8_STAGE(PG8_SA(1, 0), a3, voffA);
            PG8_WAIT_V(8); PG8_WAIT_L(0); PG8_BAR; PG8_MMA(1, 0, At, B0); PG8_MMA(1, 1, At, B1); PG8_BAR; PG8_SCHED;
            } else {
            PG8_LDB(B0, 0, 0); PG8_SCHED; PG8_LDA(At, 0, 0); PG8_STAGE(PG8_SA(1, 1), a1 + hstep, voffA);
            PG8_WAIT_L(8); PG8_BAR; PG8_WAIT_L(0); PG8_MMA(0, 0, At, B0); PG8_BAR; PG8_SCHED;
            PG8_LDB(B1, 0, 1); PG8_STAGE(PG8_SB(0, 0), b2, voffB);
            PG8_BAR; PG8_WAIT_L(0); PG8_MMA(0, 1, At, B1); PG8_BAR;
            PG8_LDA(At, 0, 1); PG8_STAGE(PG8_SA(0, 0), a2, voffA);
            PG8_BAR; PG8_WAIT_L(0); PG8_MMA(1, 0, At, B0); PG8_BAR; PG8_SCHED;
            PG8_STAGE(PG8_SB(0, 1), b2 + hstep, voffB);
            PG8_WAIT_V(6); PG8_BAR; PG8_MMA(1, 1, At, B1); PG8_BAR;
            PG8_LDB(B0, 1, 0); PG8_SCHED; PG8_LDA(At, 1, 0); PG8_STAGE(PG8_SA(0, 1), a2 + hstep, voffA);
            PG8_WAIT_L(8); PG8_BAR; PG8_WAIT_L(0); PG8_MMA(0, 0, At, B0); PG8_BAR; PG8_SCHED;
            PG8_LDB(B1, 1, 1); PG8_STAGE(PG8_SB(1, 0), b3, voffB);
            PG8_BAR; PG8_WAIT_L(0); PG8_MMA(0, 1, At, B1); PG8_BAR;
            PG8_LDA(At, 1, 1); PG8_STAGE(PG8_SA(1, 0), a3, voffA);
            PG8_BAR; PG8_WAIT_L(0); PG8_MMA(1, 0, At, B0); PG8_BAR; PG8_SCHED;
            PG8_STAGE(PG8_SB(1, 1), b3 + hstep, voffB);
            PG8_WAIT_V(6); PG8_BAR; PG8_MMA(1, 1, At, B1); PG8_BAR;
            }
        }
        if constexpr (ALIGN_EPI) { if (wr == 0) PG8_BAR; }
        if constexpr (!Epi::AFTER_DRAIN) { E(acc, cur, wr, wc, fr, fq); S.done(cur); }
        if (!has_next) break;
#pragma unroll
        for (int a = 0; a < 2; ++a)
#pragma unroll
            for (int b = 0; b < 2; ++b)
#pragma unroll
                for (int m = 0; m < 4; ++m)
#pragma unroll
                    for (int n = 0; n < 2; ++n) acc[a][b][m][n] = (f32x4){0.f, 0.f, 0.f, 0.f};
        cur = nxt; cA = nA; cB = nB; ++ui;
        if constexpr (ALIGN_EPI) { if (wr == 1) PG8_BAR; }
    }
    PG8_WAIT_V(0);
    if constexpr (!ALIGN_EPI) { if (wr == 0) PG8_BAR; }
    PG8_BAR;
    if constexpr (Epi::AFTER_DRAIN) { E.fused(acc, cur, wr, wc, fr, fq, lds, wid, lane); S.done(cur); }
#undef PG8_SA
#undef PG8_SB
#undef PG8_STAGE
#undef PG8_LDA
#undef PG8_LDB
#undef PG8_MMA
#undef PG8_WAIT_V
#undef PG8_WAIT_L
#undef PG8_BAR
#undef PG8_SCHED
}
}
#define LAS __attribute__((address_space(3)))
typedef unsigned short bf16;
typedef short bf16x8 __attribute__((ext_vector_type(8)));
typedef float f32x4 __attribute__((ext_vector_type(4)));
typedef float f32x16 __attribute__((ext_vector_type(16)));
typedef unsigned u32x4 __attribute__((ext_vector_type(4)));
typedef unsigned u32x2 __attribute__((ext_vector_type(2)));

constexpr int DM = 1024, NB = 16, SEQ = 2048, DB = 128, DT = 4;
constexpr int TP = NB * SEQ, TS = DB * DT, MT = TP + TS, M1 = 33536;
constexpr int RW = 1792, QW = 768;
constexpr int R_OFF = 0, W_OFF = 512, K_OFF = 576, V_OFF = 1088, A_OFF = 1600, G_OFF = 1664;
constexpr float RMS_EPS = 1e-6f, GN_EPS = 64e-5f, QSCALE = 0.125f;

constexpr size_t WS_WIN = 0, WS_WOUT = WS_WIN + (size_t)2560 * 1024 * 2, WS_WUP = WS_WOUT + (size_t)1024 * 1024 * 2, WS_WDN = WS_WUP + (size_t)4096 * 1024 * 2,
                 WS_WL = WS_WDN + (size_t)4096 * 1024 * 2, WS_SSQ = WS_WL + (size_t)1536 * 256 * 2, WS_HN = 25165824,
                 WS_QKV = WS_HN + (size_t)M1 * 1024 * 2, WS_P = WS_QKV + (size_t)M1 * QW * 2, WS_L = WS_P + (size_t)M1 * RW * 2, WS_D = WS_L + (size_t)MT * 256 * 2,
                 WS_A = WS_D + (size_t)MT * 512 * 4, WS_G = WS_A + (size_t)MT * 512 * 2, WS_MIX = WS_G + (size_t)MT * 512 * 2, WS_KT = WS_MIX + (size_t)MT * 1024 * 2, WS_G16 = WS_KT + (size_t)TP * 512 * 2, WS_BS = WS_G16 + (size_t)(TP / 16) * 512 * 4, WS_END = WS_BS + (size_t)TP * 8 * 4;
constexpr size_t WS_Y = WS_HN, WS_BON = WS_MIX + 1024, WS_X1G = WS_A, WS_U = WS_HN;
constexpr size_t WS_BAR = WS_SSQ + (size_t)MT * 4;
static_assert(WS_BAR + 3456 * 4 + 256 <= WS_HN, "ws map");
static_assert((size_t)4 * 768 * 2560 * 4 <= (size_t)MT * 512 * 4 && (size_t)4 * 512 * 1024 * 4 <= (size_t)M1 * QW * 2 && (size_t)4 * 512 * 4096 * 4 <= (size_t)MT * 1024 * 2 && (size_t)16 * 512 * 1024 * 4 <= (size_t)MT * 1024 * 2, "split-K scratch");
static_assert(WS_U + (size_t)MT * 4096 * 2 <= WS_A, "U overlay");
static_assert(WS_Y + (size_t)MT * 512 * 4 <= WS_QKV && WS_X1G + (size_t)MT * 1024 * 2 <= WS_MIX, "overlays");

constexpr size_t O_YP = 0, O_YS = O_YP + (size_t)TP * 1024, O_KP = O_YS + (size_t)TS * 1024, O_VP = O_KP + 262144, O_WP = O_VP + 262144, O_SP = O_WP + 524288,
                 O_KS = O_SP + 16384, O_VS = O_KS + 2097152, O_WS = O_VS + 2097152, O_SS = O_WS + 4194304, O_END = O_SS + 131072;

constexpr int LDS_BYTES = 8 * 20224 + 1536 + 16;
constexpr int NTHR = 512;

struct Args { const float* in[26]; float* out; unsigned char* ws; int ph_lo, ph_hi; };

__device__ __forceinline__ float bf2f(unsigned short v) { return __uint_as_float((unsigned)v << 16); }
__device__ __forceinline__ float bflo(unsigned v) { return __uint_as_float(v << 16); }
__device__ __forceinline__ float bfhi(unsigned v) { return __uint_as_float(v & 0xffff0000u); }
typedef float f32x2_t __attribute__((ext_vector_type(2)));
typedef __bf16 bf16x2_t __attribute__((ext_vector_type(2)));
__device__ __forceinline__ unsigned pk2c(float lo, float hi) { const f32x2_t v = {lo, hi}; const bf16x2_t b = __builtin_convertvector(v, bf16x2_t); return __builtin_bit_cast(unsigned, b); }
__device__ __forceinline__ unsigned pk2(float lo, float hi) { return pg8::cvt_pk_bf16(lo, hi); }
__device__ __forceinline__ unsigned pk2n(float lo, float hi) { unsigned r; asm volatile("v_cvt_pk_bf16_f32 %0, %1, %2\n\ts_nop 1" : "=v"(r) : "v"(lo), "v"(hi)); return r; }
__device__ __forceinline__ float wave_sum(float v) {
#pragma unroll
    for (int o = 32; o >= 1; o >>= 1) v += __shfl_xor(v, o);
    return v;
}
__device__ __forceinline__ float wave_max(float v) {
#pragma unroll
    for (int o = 32; o >= 1; o >>= 1) v = fmaxf(v, __shfl_xor(v, o));
    return v;
}
template <int CTRL> __device__ __forceinline__ float dpp_mov(float x) { return __builtin_bit_cast(float, __builtin_amdgcn_update_dpp(0, __builtin_bit_cast(int, x), CTRL, 0xF, 0xF, true)); }
__device__ __forceinline__ float sum16(float x) {
    x += dpp_mov<0xB1>(x);
    x += dpp_mov<0x4E>(x);
    x += dpp_mov<0x124>(x);
    x += dpp_mov<0x128>(x);
    return x;
}

__device__ __forceinline__ void transpose_tile(const float* __restrict__ W, int K, int N, bf16* WT, int kt, int nt, LAS float* scr, int tid) {
#pragma unroll
    for (int i = 0; i < 8; ++i) { const int idx = tid + i * NTHR, kk = idx >> 6, nn = idx & 63; scr[kk * 65 + nn] = W[(size_t)(kt * 64 + kk) * N + nt * 64 + nn]; }
    __syncthreads();
    { const int n = tid >> 3, k8 = (tid & 7) * 8; float v[8];
#pragma unroll
      for (int j = 0; j < 8; ++j) v[j] = scr[(k8 + j) * 65 + n];
      u32x4 w; w.x = pk2(v[0], v[1]); w.y = pk2(v[2], v[3]); w.z = pk2(v[4], v[5]); w.w = pk2(v[6], v[7]);
      *(u32x4*)(WT + (size_t)(nt * 64 + n) * K + kt * 64 + k8) = w; }
    __syncthreads();
}

__device__ __forceinline__ void phase0(const Args& a, LAS unsigned char* lds) {
    const int tid = threadIdx.x, lane = tid & 63, wave = tid >> 6, G = gridDim.x, bx = blockIdx.x;
    unsigned char* ws = a.ws;
    LAS float* scr = (LAS float*)lds;
    {
#define TILE_OF(it_, W_, K_, N_, WT_, kt_, nt_) do { if ((it_) < 640) { W_ = a.in[7]; K_ = 1024; N_ = 2560; WT_ = (bf16*)(ws + WS_WIN); kt_ = (it_) / 40; nt_ = (it_) % 40; } \
        else if ((it_) < 896) { const int j_ = (it_) - 640; W_ = a.in[22]; K_ = 1024; N_ = 1024; WT_ = (bf16*)(ws + WS_WOUT); kt_ = j_ / 16; nt_ = j_ % 16; } \
        else if ((it_) < 1920) { const int j_ = (it_) - 896; W_ = a.in[24]; K_ = 1024; N_ = 4096; WT_ = (bf16*)(ws + WS_WUP); kt_ = j_ / 64; nt_ = j_ % 64; } \
        else { const int j_ = (it_) - 1920; W_ = a.in[25]; K_ = 4096; N_ = 1024; WT_ = (bf16*)(ws + WS_WDN); kt_ = j_ / 16; nt_ = j_ % 16; } } while (0)
        constexpr int NTILE = 640 + 256 + 1024 + 1024;
        float rg[8]; const float* W = nullptr; int K = 0, N = 0, kt = 0, nt = 0; bf16* WT = nullptr;
        int it = bx;
        if (it < NTILE) { TILE_OF(it, W, K, N, WT, kt, nt);
#pragma unroll
            for (int i = 0; i < 8; ++i) { const int idx = tid + i * NTHR; rg[i] = W[(size_t)(kt * 64 + (idx >> 6)) * N + nt * 64 + (idx & 63)]; } }
#pragma unroll 1
        for (; it < NTILE; it += G) {
#pragma unroll
            for (int i = 0; i < 8; ++i) { const int idx = tid + i * NTHR; scr[(idx >> 6) * 65 + (idx & 63)] = rg[i]; }
            __syncthreads();
            bf16* cWT = WT; const int cK = K, ckt = kt, cnt = nt;
            if (it + G < NTILE) { TILE_OF(it + G, W, K, N, WT, kt, nt);
#pragma unroll
                for (int i = 0; i < 8; ++i) { const int idx = tid + i * NTHR; rg[i] = W[(size_t)(kt * 64 + (idx >> 6)) * N + nt * 64 + (idx & 63)]; } }
            { const int n = tid >> 3, k8 = (tid & 7) * 8; float v[8];
#pragma unroll
              for (int j = 0; j < 8; ++j) v[j] = scr[(k8 + j) * 65 + n];
              u32x4 w; w.x = pk2(v[0], v[1]); w.y = pk2(v[2], v[3]); w.z = pk2(v[4], v[5]); w.w = pk2(v[6], v[7]);
              *(u32x4*)(cWT + (size_t)(cnt * 64 + n) * cK + ckt * 64 + k8) = w; }
            __syncthreads();
        }
#undef TILE_OF
    }
    { bf16* WL = (bf16*)(ws + WS_WL); const float* wd = a.in[13]; const float* au = a.in[15]; const float* gu = a.in[16];
      for (int idx = bx * NTHR + tid; idx < 1536 * 256; idx += G * NTHR) { const int n = idx >> 8, k = idx & 255; float v = 0.f;
          if (n < 512) { if (k < 64) v = wd[k * 512 + n]; } else if (n < 1024) { if (k >= 64 && k < 128) v = au[(k - 64) * 512 + (n - 512)]; } else { if (k >= 128) v = gu[(k - 128) * 512 + (n - 1024)]; }
          WL[idx] = (bf16)(pk2(v, 0.f) & 0xffffu); } }
    { float* SSQ = (float*)(ws + WS_SSQ); for (int idx = bx * NTHR + tid; idx < MT; idx += G * NTHR) SSQ[idx] = 0.f; }
    { bf16* HN = (bf16*)(ws + WS_HN); const float* g1 = a.in[6];
      f32x4 gv[4];
#pragma unroll
      for (int i = 0; i < 4; ++i) gv[i] = *(const f32x4*)(g1 + lane * 4 + i * 256);
#pragma unroll 1
      for (int row0_ = (bx * 8 + wave) * 2; row0_ < M1; row0_ += G * 16) {
          f32x4 v[2][4];
#pragma unroll
          for (int u = 0; u < 2; ++u) { const int row = row0_ + u;
              const float* src = row < TP ? a.in[0] + (size_t)row * 1024 : (row < MT ? a.in[1] + (size_t)(row - TP) * 1024 : (row < MT + DB ? a.in[5] + (size_t)(row - MT) * 1024 : nullptr));
#pragma unroll
              for (int i = 0; i < 4; ++i) v[u][i] = src ? *(const f32x4*)(src + lane * 4 + i * 256) : (f32x4){0.f, 0.f, 0.f, 0.f}; }
#pragma unroll
          for (int u = 0; u < 2; ++u) { const int row = row0_ + u; float ss = 0.f;
#pragma unroll
              for (int i = 0; i < 4; ++i) ss += (v[u][i][0] * v[u][i][0] + v[u][i][1] * v[u][i][1]) + (v[u][i][2] * v[u][i][2] + v[u][i][3] * v[u][i][3]);
              if (row < MT) { ss = wave_sum(ss); const float rs = rsqrtf(ss * (1.0f / 1024.0f) + RMS_EPS);
#pragma unroll
                  for (int i = 0; i < 4; ++i) v[u][i] = v[u][i] * rs * gv[i]; }
              float* so = nullptr;
              if (row < TP) { if ((row & (SEQ - 1)) == SEQ - 1) so = a.out + O_SP + (size_t)(row >> 11) * 1024; }
              else if (row < MT) { const int r = row - TP; if ((r & 3) == 3) so = a.out + O_SS + (size_t)(r >> 2) * 1024; }
#pragma unroll
              for (int i = 0; i < 4; ++i) { u32x2 w; w.x = pk2(v[u][i][0], v[u][i][1]); w.y = pk2(v[u][i][2], v[u][i][3]); *(u32x2*)(HN + (size_t)row * 1024 + lane * 4 + i * 256) = w;
                  if (so) *(f32x4*)(so + lane * 4 + i * 256) = v[u][i]; } }
      } }
}

__device__ __forceinline__ int prev_row_of(int row) {
    if (row < TP) return (row & (SEQ - 1)) ? row - 1 : -1;
    const int r = row - TP; return (r & 3) ? row - 1 : MT + (r >> 2);
}
__device__ __forceinline__ void unpack8(const u32x4 w, float* v) { v[0] = bflo(w.x); v[1] = bfhi(w.x); v[2] = bflo(w.y); v[3] = bfhi(w.y); v[4] = bflo(w.z); v[5] = bfhi(w.z); v[6] = bflo(w.w); v[7] = bfhi(w.w); }
__device__ __forceinline__ void phase_lora_in(const Args& a) {
    const bf16* P = (const bf16*)(a.ws + WS_P); bf16* L = (bf16*)(a.ws + WS_L); const float* mu = a.in[11];
    const int nthr = gridDim.x * NTHR;
#pragma unroll 1
    for (int idx0 = blockIdx.x * NTHR + threadIdx.x; idx0 < MT * 32; idx0 += 4 * nthr) {
        u32x4 pw[4], qw[4]; int pcs[4];
#pragma unroll
        for (int u = 0; u < 4; ++u) { const int idx = idx0 + u * nthr; pw[u] = qw[u] = (u32x4){0u, 0u, 0u, 0u}; pcs[u] = 0;
            if (idx < MT * 32) { const int row = idx >> 5, c = (idx & 31) * 8; const int pc = c < 64 ? W_OFF + c : (c < 128 ? A_OFF + (c - 64) : G_OFF + (c - 128)); const int pr = prev_row_of(row);
                pcs[u] = pc; pw[u] = *(const u32x4*)(P + (size_t)row * RW + pc); if (pr >= 0) qw[u] = *(const u32x4*)(P + (size_t)pr * RW + pc); } }
#pragma unroll
        for (int u = 0; u < 4; ++u) { const int idx = idx0 + u * nthr;
            if (idx < MT * 32) { const int row = idx >> 5, c = (idx & 31) * 8, pc = pcs[u];
                float p[8], q[8]; unpack8(pw[u], p); unpack8(qw[u], q);
                const f32x4 m0 = *(const f32x4*)(mu + pc), m1 = *(const f32x4*)(mu + pc + 4);
                float o[8];
#pragma unroll
                for (int j = 0; j < 8; ++j) { const float m = j < 4 ? m0[j] : m1[j - 4]; const float x = p[j] + (q[j] - p[j]) * m;
                    o[j] = c < 64 ? 1.0f - 2.0f * __builtin_amdgcn_rcpf(1.0f + __expf(2.0f * x)) : (c < 128 ? x : __builtin_amdgcn_rcpf(1.0f + __expf(-x))); }
                u32x4 w; w.x = pk2(o[0], o[1]); w.y = pk2(o[2], o[3]); w.z = pk2(o[4], o[5]); w.w = pk2(o[6], o[7]);
                *(u32x4*)(L + (size_t)row * 256 + c) = w; } }
    }
}

constexpr int KROW = 144;
constexpr int VROW = 528;
constexpr int ATT_K = 0, ATT_V = 256 * KROW;
__device__ __forceinline__ int crow(int reg, int h) { return (reg & 3) + 8 * (reg >> 2) + 4 * h; }
#define MFMA32(a, b, c) __builtin_amdgcn_mfma_f32_32x32x16_bf16((a), (b), (c), 0, 0, 0)

__device__ __forceinline__ void attn_prompt_unit(const Args& a, LAS unsigned char* lds, int unit) {
    const int tid = threadIdx.x, lane = tid & 63, wave = tid >> 6;
    const int kvh = unit & 1, n = (unit >> 1) & 15, b = unit >> 5;
    const bf16* QKV = (const bf16*)(a.ws + WS_QKV); bf16* MIX = (bf16*)(a.ws + WS_MIX);
    const float* kg = a.in[9]; const float* qg = a.in[8];
    { const int jj = tid >> 1, hf = tid & 1; const int t = n * 128 - 128 + jj;
      float kx[32], vx[32];
      if (t >= 0) { const bf16* src = QKV + (size_t)(b * SEQ + t) * QW + 512 + kvh * 64 + hf * 32;
#pragma unroll
          for (int i = 0; i < 4; ++i) { unpack8(*(const u32x4*)(src + i * 8), kx + i * 8); unpack8(*(const u32x4*)(src + 128 + i * 8), vx + i * 8); } }
      else {
#pragma unroll
          for (int i = 0; i < 32; ++i) { kx[i] = 0.f; vx[i] = 0.f; } }
      float ss = 0.f;
#pragma unroll
      for (int i = 0; i < 32; ++i) ss += kx[i] * kx[i];
      ss += __shfl_xor(ss, 1);
      const float rs = rsqrtf(ss * (1.0f / 64.0f) + RMS_EPS);
#pragma unroll
      for (int i = 0; i < 32; ++i) kx[i] = kx[i] * rs * kg[hf * 32 + i];
#pragma unroll
      for (int i = 0; i < 4; ++i) { u32x4 w; w.x = pk2(kx[i * 8], kx[i * 8 + 1]); w.y = pk2(kx[i * 8 + 2], kx[i * 8 + 3]); w.z = pk2(kx[i * 8 + 4], kx[i * 8 + 5]); w.w = pk2(kx[i * 8 + 6], kx[i * 8 + 7]);
          *(LAS u32x4*)(lds + ATT_K + jj * KROW + hf * 64 + i * 16) = w; }
#pragma unroll
      for (int i = 0; i < 32; ++i) *(LAS bf16*)(lds + ATT_V + (hf * 32 + i) * VROW + jj * 2) = (bf16)(pk2(vx[i], 0.f) & 0xffffu);
      if (n == 15 && jj >= 128) { float* ko = a.out + O_KP + ((size_t)(b * 128 + jj - 128) * 2 + kvh) * 64 + hf * 32; float* vo = a.out + O_VP + ((size_t)(b * 128 + jj - 128) * 2 + kvh) * 64 + hf * 32;
#pragma unroll
          for (int i = 0; i < 8; ++i) { *(f32x4*)(ko + i * 4) = (f32x4){kx[i * 4], kx[i * 4 + 1], kx[i * 4 + 2], kx[i * 4 + 3]}; *(f32x4*)(vo + i * 4) = (f32x4){vx[i * 4], vx[i * 4 + 1], vx[i * 4 + 2], vx[i * 4 + 3]}; } }
    }
    __syncthreads();
    const int r = lane & 31, h = lane >> 5;
#pragma unroll 1
    for (int it = 0; it < 2; ++it) {
        const int su = wave + 8 * it, g = su >> 2, q0 = (su & 3) * 32, head = kvh * 4 + g;
        const int tok = b * SEQ + n * 128 + q0 + r;
        bf16x8 qb[4];
        { float qx[32]; const bf16* src = QKV + (size_t)tok * QW + head * 64 + 8 * h;
#pragma unroll
          for (int ds = 0; ds < 4; ++ds) unpack8(*(const u32x4*)(src + ds * 16), qx + ds * 8);
          float ss = 0.f;
#pragma unroll
          for (int i = 0; i < 32; ++i) ss += qx[i] * qx[i];
          ss += __shfl_xor(ss, 32);
          const float rs = rsqrtf(ss * (1.0f / 64.0f) + RMS_EPS) * QSCALE;
#pragma unroll
          for (int ds = 0; ds < 4; ++ds) { u32x4 w; const float* gq = qg + ds * 16 + 8 * h; const float* x = qx + ds * 8;
              w.x = pk2n(x[0] * rs * gq[0], x[1] * rs * gq[1]); w.y = pk2n(x[2] * rs * gq[2], x[3] * rs * gq[3]); w.z = pk2n(x[4] * rs * gq[4], x[5] * rs * gq[5]); w.w = pk2n(x[6] * rs * gq[6], x[7] * rs * gq[7]);
              qb[ds] = __builtin_bit_cast(bf16x8, w); } }
        f32x16 x[5];
#pragma unroll
        for (int kt = 0; kt < 5; ++kt) {
#pragma unroll
            for (int i = 0; i < 16; ++i) x[kt][i] = 0.f;
#pragma unroll
            for (int ds = 0; ds < 4; ++ds) { const bf16x8 ka = *(const LAS bf16x8*)(lds + ATT_K + (q0 + kt * 32 + r) * KROW + (ds * 16 + 8 * h) * 2); x[kt] = MFMA32(ka, qb[ds], x[kt]); } }
        const float sink = a.in[10][head];
        float m = sink;
#pragma unroll
        for (int kt = 0; kt < 5; ++kt)
#pragma unroll
            for (int i = 0; i < 16; ++i) { const int jr = kt * 32 + crow(i, h); const int rel = jr - r; const bool ok = rel > 0 && rel <= 128 && (n > 0 || q0 + jr >= 128);
                x[kt][i] = ok ? x[kt][i] : -INFINITY; m = fmaxf(m, x[kt][i]); }
        m = fmaxf(m, __shfl_xor(m, 32));
        float sum = 0.f;
#pragma unroll
        for (int kt = 0; kt < 5; ++kt)
#pragma unroll
            for (int i = 0; i < 16; ++i) { x[kt][i] = __expf(x[kt][i] - m); sum += x[kt][i]; }
        sum += __shfl_xor(sum, 32);
        const float inv = 1.0f / (sum + __expf(sink - m));
        f32x16 y[2];
#pragma unroll
        for (int dt = 0; dt < 2; ++dt)
#pragma unroll
            for (int i = 0; i < 16; ++i) y[dt][i] = 0.f;
#pragma unroll
        for (int kt = 0; kt < 5; ++kt)
#pragma unroll
            for (int s = 0; s < 2; ++s) { u32x4 pw; pw.x = pk2n(x[kt][8 * s], x[kt][8 * s + 1]); pw.y = pk2n(x[kt][8 * s + 2], x[kt][8 * s + 3]); pw.z = pk2n(x[kt][8 * s + 4], x[kt][8 * s + 5]); pw.w = pk2n(x[kt][8 * s + 6], x[kt][8 * s + 7]);
                const bf16x8 ps = __builtin_bit_cast(bf16x8, pw);
#pragma unroll
                for (int dt = 0; dt < 2; ++dt) { const LAS unsigned char* vp = lds + ATT_V + (dt * 32 + r) * VROW + (q0 + kt * 32 + 16 * s + 4 * h) * 2;
                    const u32x2 lo = *(const LAS u32x2*)vp, hi = *(const LAS u32x2*)(vp + 16); u32x4 vw; vw.x = lo.x; vw.y = lo.y; vw.z = hi.x; vw.w = hi.y;
                    y[dt] = MFMA32(__builtin_bit_cast(bf16x8, vw), ps, y[dt]); } }
        bf16* orow = MIX + (size_t)tok * 1024 + head * 64;
#pragma unroll
        for (int dt = 0; dt < 2; ++dt)
#pragma unroll
            for (int gq = 0; gq < 4; ++gq) { u32x2 w; w.x = pk2(y[dt][4 * gq] * inv, y[dt][4 * gq + 1] * inv); w.y = pk2(y[dt][4 * gq + 2] * inv, y[dt][4 * gq + 3] * inv);
                *(u32x2*)(orow + dt * 32 + 8 * gq + 4 * h) = w; }
    }
    __syncthreads();
}

__device__ __forceinline__ void attn_sample_unit(const Args& a, LAS unsigned char* lds, int unit) {
    const int tid = threadIdx.x, lane = tid & 63, wave = tid >> 6;
    const int kvh = unit & 1, b = unit >> 1;
    const bf16* QKV = (const bf16*)(a.ws + WS_QKV); bf16* MIX = (bf16*)(a.ws + WS_MIX);
    constexpr int KS = 68;
    LAS float* Kf = (LAS float*)lds;
    LAS float* Vf = Kf + 132 * KS;
    LAS float* Qf = Vf + 132 * 64;
    LAS float* Pf = Qf + 16 * 64;
    const float* ck = a.in[2]; const float* cv = a.in[3];
    for (int idx = tid; idx < 128 * 16; idx += NTHR) { const int jj = idx >> 4, d = (idx & 15) * 4; const size_t go = ((size_t)(b * 128 + jj) * 2 + kvh) * 64 + d;
        *(LAS f32x4*)(Kf + jj * KS + d) = *(const f32x4*)(ck + go); *(LAS f32x4*)(Vf + jj * 64 + d) = *(const f32x4*)(cv + go); }
    if (wave < 4) { const int t = wave; const bf16* src = QKV + (size_t)(TP + b * 4 + t) * QW + 512 + kvh * 64;
        const float kx = bf2f(src[lane]), vx = bf2f(src[128 + lane]); const float ss = wave_sum(kx * kx);
        Kf[(128 + t) * KS + lane] = kx * rsqrtf(ss * (1.0f / 64.0f) + RMS_EPS) * a.in[9][lane]; Vf[(128 + t) * 64 + lane] = vx; }
#pragma unroll
    for (int i = 0; i < 2; ++i) { const int row = wave * 2 + i, g = row >> 2, t = row & 3; const bf16* src = QKV + (size_t)(TP + b * 4 + t) * QW + (kvh * 4 + g) * 64;
        const float qx = bf2f(src[lane]); const float ss = wave_sum(qx * qx); Qf[row * 64 + lane] = qx * rsqrtf(ss * (1.0f / 64.0f) + RMS_EPS) * a.in[8][lane] * QSCALE; }
    __syncthreads();
    for (int idx = tid; idx < 128 * 16; idx += NTHR) { const int jj = idx >> 4, d = (idx & 15) * 4; const size_t go = ((size_t)(b * 128 + jj) * 2 + kvh) * 64 + d;
        *(f32x4*)(a.out + O_KS + go) = *(const LAS f32x4*)(Kf + (jj + 4) * KS + d); *(f32x4*)(a.out + O_VS + go) = *(const LAS f32x4*)(Vf + (jj + 4) * 64 + d); }
    for (int idx = tid; idx < 16 * 132; idx += NTHR) { const int row = idx / 132, j = idx - row * 132, t = row & 3; float s = -INFINITY;
        if (j > t && j <= t + 128) { f32x4 acc = (f32x4){0.f, 0.f, 0.f, 0.f};
#pragma unroll
            for (int d = 0; d < 64; d += 4) acc = acc + *(const LAS f32x4*)(Qf + row * 64 + d) * *(const LAS f32x4*)(Kf + j * KS + d);
            s = (acc[0] + acc[1]) + (acc[2] + acc[3]); }
        Pf[row * 136 + j] = s; }
    __syncthreads();
#pragma unroll
    for (int i = 0; i < 2; ++i) { const int row = wave * 2 + i, g = row >> 2; const float sink = a.in[10][kvh * 4 + g];
        float s0 = Pf[row * 136 + lane], s1 = Pf[row * 136 + 64 + lane], s2 = lane < 4 ? Pf[row * 136 + 128 + lane] : -INFINITY;
        float m = wave_max(fmaxf(fmaxf(s0, s1), s2)); m = fmaxf(m, sink);
        s0 = __expf(s0 - m); s1 = __expf(s1 - m); s2 = __expf(s2 - m);
        const float inv = 1.0f / (wave_sum(s0 + s1 + s2) + __expf(sink - m));
        Pf[row * 136 + lane] = s0 * inv; Pf[row * 136 + 64 + lane] = s1 * inv; if (lane < 4) Pf[row * 136 + 128 + lane] = s2 * inv; }
    __syncthreads();
    if (tid < 256) { const int row = tid >> 4, d = (tid & 15) * 4, g = row >> 2, t = row & 3; f32x4 o = (f32x4){0.f, 0.f, 0.f, 0.f};
#pragma unroll 4
        for (int j = 0; j < 132; ++j) o = o + *(const LAS f32x4*)(Vf + j * 64 + d) * Pf[row * 136 + j];
        u32x2 w; w.x = pk2(o[0], o[1]); w.y = pk2(o[2], o[3]);
        *(u32x2*)(MIX + (size_t)(TP + b * 4 + t) * 1024 + (kvh * 4 + g) * 64 + d) = w; }
    __syncthreads();
}

constexpr int SC_TOK = 32, SC_BUF = 6 * SC_TOK * 64 * 4;
struct ScanRaw { u32x2 pr, qr, pk, qk, pv, qv, aa; f32x4 dd; };
__device__ __forceinline__ f32x4 unpack4(const u32x2 w) { return (f32x4){bflo(w.x), bfhi(w.x), bflo(w.y), bfhi(w.y)}; }

__device__ __forceinline__ void scan_unit(const Args& a, LAS unsigned char* lds, int row0, int T, int prev0, const float* s_in, float* s_out, int h, int half) {
    const int tid = threadIdx.x, rl = tid >> 4, cl = tid & 15, i = half * 32 + rl, j0 = cl * 4;
    const bf16* P = (const bf16*)(a.ws + WS_P); const bf16* Aa = (const bf16*)(a.ws + WS_A); const float* Dd = (const float*)(a.ws + WS_D);
    float* Y = (float*)(a.ws + WS_Y); bf16* BON = (bf16*)(a.ws + WS_BON);
    const int ch = h * 64 + j0;
    const f32x4 mu_r = *(const f32x4*)(a.in[11] + R_OFF + ch), mu_k = *(const f32x4*)(a.in[11] + K_OFF + ch), mu_v = *(const f32x4*)(a.in[11] + V_OFF + ch);
    const f32x4 kkw = *(const f32x4*)(a.in[17] + ch), kaw = *(const f32x4*)(a.in[18] + ch), rkw = *(const f32x4*)(a.in[19] + ch);
    f32x4 s = s_in ? *(const f32x4*)(s_in + i * 64 + j0) : (f32x4){0.f, 0.f, 0.f, 0.f};
    const int nch = (T + SC_TOK - 1) / SC_TOK;
    const int tt = rl;
    ScanRaw raw;
#define SC_LOAD(c) do { const int t_ = (c) * SC_TOK + tt; if (t_ < T) { const int row_ = row0 + t_; const int pr_ = t_ == 0 ? prev0 : row_ - 1; \
        const bf16* p_ = P + (size_t)row_ * RW + ch; raw.pr = *(const u32x2*)(p_ + R_OFF); raw.pk = *(const u32x2*)(p_ + K_OFF); raw.pv = *(const u32x2*)(p_ + V_OFF); \
        if (pr_ >= 0) { const bf16* q_ = P + (size_t)pr_ * RW + ch; raw.qr = *(const u32x2*)(q_ + R_OFF); raw.qk = *(const u32x2*)(q_ + K_OFF); raw.qv = *(const u32x2*)(q_ + V_OFF); } \
        else { raw.qr = (u32x2){0u, 0u}; raw.qk = (u32x2){0u, 0u}; raw.qv = (u32x2){0u, 0u}; } \
        raw.aa = *(const u32x2*)(Aa + (size_t)row_ * 512 + ch); raw.dd = *(const f32x4*)(Dd + (size_t)row_ * 512 + ch); } } while (0)
#define SC_STAGE(c) do { const int t_ = (c) * SC_TOK + tt; if (t_ < T) { const int row_ = row0 + t_; LAS float* B_ = (LAS float*)(lds + ((c) & 1) * SC_BUF) + tt * 64 + j0; \
        f32x4 xr = unpack4(raw.pr), xk = unpack4(raw.pk), xv = unpack4(raw.pv); f32x4 av_ = unpack4(raw.aa); f32x4 dv_ = raw.dd; \
        _Pragma("unroll") for (int e_ = 0; e_ < 4; ++e_) { av_[e_] = 1.0f / (1.0f + __expf(-av_[e_])); dv_[e_] = __expf(-0.60653066f / (1.0f + __expf(-dv_[e_]))); } \
        xr = xr + (unpack4(raw.qr) - xr) * mu_r; xk = xk + (unpack4(raw.qk) - xk) * mu_k; xv = xv + (unpack4(raw.qv) - xv) * mu_v; \
        f32x4 kk = xk * kkw; float ss_ = sum16((kk[0] * kk[0] + kk[1] * kk[1]) + (kk[2] * kk[2] + kk[3] * kk[3])); \
        kk = kk * (1.0f / fmaxf(sqrtf(ss_), 1e-12f)); \
        const f32x4 kh = xk * (1.0f + (av_ - 1.0f) * kaw); \
        const f32x4 rk_ = xr * kh * rkw; const float bs_ = sum16((rk_[0] + rk_[1]) + (rk_[2] + rk_[3])); \
        if ((cl >> 3) == half) { const f32x4 bo = xv * bs_; u32x2 w_; w_.x = pk2(bo[0], bo[1]); w_.y = pk2(bo[2], bo[3]); *(u32x2*)(BON + (size_t)row_ * 1024 + ch) = w_; } \
        *(LAS f32x4*)(B_) = -kk; *(LAS f32x4*)(B_ + SC_TOK * 64) = kk * av_; *(LAS f32x4*)(B_ + 2 * SC_TOK * 64) = dv_; \
        *(LAS f32x4*)(B_ + 3 * SC_TOK * 64) = kh; *(LAS f32x4*)(B_ + 4 * SC_TOK * 64) = xr; *(LAS f32x4*)(B_ + 5 * SC_TOK * 64) = xv; } } while (0)
    SC_LOAD(0); SC_STAGE(0);
    __syncthreads();
#pragma unroll 1
    for (int c = 0; c < nch; ++c) {
        if (c + 1 < nch) SC_LOAD(c + 1);
        const LAS float* B = (const LAS float*)(lds + (c & 1) * SC_BUF);
        const int nt = min(SC_TOK, T - c * SC_TOK);
        float* yp = Y + (size_t)(row0 + c * SC_TOK) * 512 + h * 64 + i;
        if (nt == SC_TOK) {
            f32x4 a4 = *(const LAS f32x4*)(B + j0), b4 = *(const LAS f32x4*)(B + SC_TOK * 64 + j0), d4 = *(const LAS f32x4*)(B + 2 * SC_TOK * 64 + j0),
                  k4 = *(const LAS f32x4*)(B + 3 * SC_TOK * 64 + j0), r4 = *(const LAS f32x4*)(B + 4 * SC_TOK * 64 + j0);
            float v = B[5 * SC_TOK * 64 + i];
#pragma unroll 1
            for (int tb = 0; tb < SC_TOK; tb += 16) {
                float ykeep = 0.f;
#pragma unroll
                for (int u = 0; u < 16; ++u) {
                    const int tn = (tb + u + 1) & (SC_TOK - 1);
                    const f32x4 na = *(const LAS f32x4*)(B + tn * 64 + j0), nb = *(const LAS f32x4*)(B + SC_TOK * 64 + tn * 64 + j0), nd = *(const LAS f32x4*)(B + 2 * SC_TOK * 64 + tn * 64 + j0),
                                nk = *(const LAS f32x4*)(B + 3 * SC_TOK * 64 + tn * 64 + j0), nr = *(const LAS f32x4*)(B + 4 * SC_TOK * 64 + tn * 64 + j0);
                    const float nv = B[5 * SC_TOK * 64 + tn * 64 + i];
                    const float sa = sum16((s[0] * a4[0] + s[1] * a4[1]) + (s[2] * a4[2] + s[3] * a4[3]));
                    s = s * d4 + b4 * sa + k4 * v;
                    const float y = sum16((s[0] * r4[0] + s[1] * r4[1]) + (s[2] * r4[2] + s[3] * r4[3]));
                    ykeep = (cl == u) ? y : ykeep;
                    a4 = na; b4 = nb; d4 = nd; k4 = nk; r4 = nr; v = nv;
                }
                yp[(size_t)(tb + cl) * 512] = ykeep;
            }
        } else {
#pragma unroll 1
        for (int t = 0; t < nt; ++t) {
            const f32x4 a4 = *(const LAS f32x4*)(B + t * 64 + j0), b4 = *(const LAS f32x4*)(B + SC_TOK * 64 + t * 64 + j0), d4 = *(const LAS f32x4*)(B + 2 * SC_TOK * 64 + t * 64 + j0),
                        k4 = *(const LAS f32x4*)(B + 3 * SC_TOK * 64 + t * 64 + j0), r4 = *(const LAS f32x4*)(B + 4 * SC_TOK * 64 + t * 64 + j0);
            const float v = B[5 * SC_TOK * 64 + t * 64 + i];
            const float sa = sum16((s[0] * a4[0] + s[1] * a4[1]) + (s[2] * a4[2] + s[3] * a4[3]));
            s = s * d4 + b4 * sa + k4 * v;
            const float y = sum16((s[0] * r4[0] + s[1] * r4[1]) + (s[2] * r4[2] + s[3] * r4[3]));
            if (cl == 0) yp[(size_t)t * 512] = y;
        }
        }
        if (c + 1 < nch) SC_STAGE(c + 1);
        __syncthreads();
    }
    *(f32x4*)(s_out + i * 64 + j0) = s;
#undef SC_LOAD
#undef SC_STAGE
}

#define MFMA16(a, b, c) __builtin_amdgcn_mfma_f32_16x16x32_bf16((a), (b), (c), 0, 0, 0)
__device__ __forceinline__ void unpack16(const bf16* p, float* o) { unpack8(*(const u32x4*)p, o); unpack8(*(const u32x4*)(p + 8), o + 8); }
__device__ __forceinline__ u32x4 pack8f(const float* v) { u32x4 w; w.x = pk2c(v[0], v[1]); w.y = pk2c(v[2], v[3]); w.z = pk2c(v[4], v[5]); w.w = pk2c(v[6], v[7]); return w; }

__device__ __forceinline__ void phase_prepass(const Args& a) {
    const int lane = threadIdx.x & 63, gw = blockIdx.x * 8 + (threadIdx.x >> 6), nw = gridDim.x * 8;
    const bf16* P = (const bf16*)(a.ws + WS_P); bf16* Aa = (bf16*)(a.ws + WS_A); float* Dd = (float*)(a.ws + WS_D);
    bf16* KT = (bf16*)(a.ws + WS_KT); float* G16 = (float*)(a.ws + WS_G16); float* BS = (float*)(a.ws + WS_BS);
    const int tt = lane & 15, c0 = (lane >> 4) * 16;
    struct RawQ { u32x4 r0, r1, k0, k1, pr0, pr1, pk0, pk1, a0, a1; f32x4 d0, d1, d2, d3; } cur, nxt;
#define Q_LOAD(q_, it_) do { const int h_ = (it_) & 7, row_ = ((it_) >> 3) * 16 + tt, ch_ = h_ * 64 + c0; const bf16* p_ = P + (size_t)row_ * RW + ch_; \
        q_.r0 = *(const u32x4*)(p_ + R_OFF); q_.r1 = *(const u32x4*)(p_ + R_OFF + 8); q_.k0 = *(const u32x4*)(p_ + K_OFF); q_.k1 = *(const u32x4*)(p_ + K_OFF + 8); \
        if ((row_ & (SEQ - 1)) != 0) { q_.pr0 = *(const u32x4*)(p_ - RW + R_OFF); q_.pr1 = *(const u32x4*)(p_ - RW + R_OFF + 8); q_.pk0 = *(const u32x4*)(p_ - RW + K_OFF); q_.pk1 = *(const u32x4*)(p_ - RW + K_OFF + 8); } \
        else { q_.pr0 = q_.pr1 = q_.pk0 = q_.pk1 = (u32x4){0u, 0u, 0u, 0u}; } \
        const bf16* a_ = Aa + (size_t)row_ * 512 + ch_; q_.a0 = *(const u32x4*)a_; q_.a1 = *(const u32x4*)(a_ + 8); \
        const float* d_ = Dd + (size_t)row_ * 512 + ch_; q_.d0 = *(const f32x4*)d_; q_.d1 = *(const f32x4*)(d_ + 4); q_.d2 = *(const f32x4*)(d_ + 8); q_.d3 = *(const f32x4*)(d_ + 12); } while (0)
    if (gw < (TP / 16) * 8) Q_LOAD(cur, gw);
#pragma unroll 1
    for (int item = gw; item < (TP / 16) * 8; item += nw) {
        const int h = item & 7, cchunk = item >> 3, row = cchunk * 16 + tt, ch = h * 64 + c0;
        if (item + nw < (TP / 16) * 8) Q_LOAD(nxt, item + nw);
        float xr[16], xk[16], aa[16];
        unpack8(cur.r0, xr); unpack8(cur.r1, xr + 8); unpack8(cur.k0, xk); unpack8(cur.k1, xk + 8); unpack8(cur.a0, aa); unpack8(cur.a1, aa + 8);
        { float pr[16]; unpack8(cur.pr0, pr); unpack8(cur.pr1, pr + 8);
#pragma unroll
          for (int g = 0; g < 4; ++g) { const f32x4 m = *(const f32x4*)(a.in[11] + R_OFF + ch + 4 * g);
#pragma unroll
              for (int e = 0; e < 4; ++e) xr[4 * g + e] += (pr[4 * g + e] - xr[4 * g + e]) * m[e]; }
          unpack8(cur.pk0, pr); unpack8(cur.pk1, pr + 8);
#pragma unroll
          for (int g = 0; g < 4; ++g) { const f32x4 m = *(const f32x4*)(a.in[11] + K_OFF + ch + 4 * g);
#pragma unroll
              for (int e = 0; e < 4; ++e) xk[4 * g + e] += (pr[4 * g + e] - xk[4 * g + e]) * m[e]; } }
        const f32x4 dpre[4] = {cur.d0, cur.d1, cur.d2, cur.d3};
        float ss = 0.f, bs = 0.f; float kkv[16], khv[16];
#pragma unroll
        for (int g = 0; g < 4; ++g) { const f32x4 kkw = *(const f32x4*)(a.in[17] + ch + 4 * g), kaw = *(const f32x4*)(a.in[18] + ch + 4 * g), rkw = *(const f32x4*)(a.in[19] + ch + 4 * g);
#pragma unroll
            for (int e4 = 0; e4 < 4; ++e4) { const int e = 4 * g + e4; aa[e] = __builtin_amdgcn_rcpf(1.0f + __expf(-aa[e]));
                kkv[e] = xk[e] * kkw[e4]; ss += kkv[e] * kkv[e];
                khv[e] = xk[e] * (1.0f + (aa[e] - 1.0f) * kaw[e4]); bs += xr[e] * khv[e] * rkw[e4]; } }
        ss += __shfl_xor(ss, 16); ss += __shfl_xor(ss, 32); bs += __shfl_xor(bs, 16); bs += __shfl_xor(bs, 32);
        const float inv = __builtin_amdgcn_rsqf(fmaxf(ss, 1e-24f));
        if (c0 == 0) BS[(size_t)row * 8 + h] = bs;
#pragma unroll
        for (int hf = 0; hf < 2; ++hf) {
            float ld[8], at[8], bt_[8], kt[8], rt[8];
            { const f32x4 d0 = dpre[2 * hf], d1 = dpre[2 * hf + 1];
#pragma unroll
              for (int e8 = 0; e8 < 4; ++e8) { ld[e8] = -0.60653066f * __builtin_amdgcn_rcpf(1.0f + __expf(-d0[e8])); ld[4 + e8] = -0.60653066f * __builtin_amdgcn_rcpf(1.0f + __expf(-d1[e8])); } }
            float gt[8];
#pragma unroll
            for (int e8 = 0; e8 < 8; ++e8) { const int e = hf * 8 + e8;
                float cs = ld[e8];
                cs += dpp_mov<0x111>(cs); cs += dpp_mov<0x112>(cs); cs += dpp_mov<0x114>(cs); cs += dpp_mov<0x118>(cs);
                const float Gt = __expf(cs), Gi = __expf(-cs), Gp = __expf(cs - ld[e8]);
                const float kn = kkv[e] * inv;
                at[e8] = -kn * Gp; bt_[e8] = kn * aa[e] * Gi; kt[e8] = khv[e] * Gi; rt[e8] = xr[e] * Gt; gt[e8] = Gt; }
            { u32x4 w0, w1;
              w0.x = pk2c(at[0], rt[0]); w0.y = pk2c(at[1], rt[1]); w0.z = pk2c(at[2], rt[2]); w0.w = pk2c(at[3], rt[3]); w1.x = pk2c(at[4], rt[4]); w1.y = pk2c(at[5], rt[5]); w1.z = pk2c(at[6], rt[6]); w1.w = pk2c(at[7], rt[7]);
              *(u32x4*)(Dd + (size_t)row * 512 + ch + hf * 8) = w0; *(u32x4*)(Dd + (size_t)row * 512 + ch + hf * 8 + 4) = w1; }
            *(u32x4*)(Aa + (size_t)row * 512 + ch + hf * 8) = pack8f(bt_);
            *(u32x4*)(KT + (size_t)row * 512 + ch + hf * 8) = pack8f(kt);
            if (tt == 15) { *(f32x4*)(G16 + (size_t)cchunk * 512 + ch + hf * 8) = (f32x4){gt[0], gt[1], gt[2], gt[3]}; *(f32x4*)(G16 + (size_t)cchunk * 512 + ch + hf * 8 + 4) = (f32x4){gt[4], gt[5], gt[6], gt[7]}; }
        }
        cur = nxt;
    }
#undef Q_LOAD
}

constexpr int BKT_ROW = 80, VT_ROW = 48;
#define SWZ(row, byteoff) ((((((byteoff) >> 4) ^ ((row) & 7)) << 4) | ((byteoff) & 15)))
constexpr int CH_AT = 0, CH_RT = 2048, CH_BKR = 4096, CH_BKT = 4096 + 4608, CH_VT = CH_BKT + 64 * BKT_ROW, CH_G = CH_VT + 64 * VT_ROW, CH_OPS = CH_G + 256, CH_BYTES = CH_OPS + 3072;
constexpr int SCAN_PAR = 8 * CH_BYTES;
static_assert(SCAN_PAR + 1536 + 16 <= LDS_BYTES, "scan LDS");
__device__ __forceinline__ void scan_mfma_unit(const Args& a, LAS unsigned char* lds, int b, int h) {
    const int tid = threadIdx.x, lane = tid & 63, wave = tid >> 6;
    const bf16* P = (const bf16*)(a.ws + WS_P); const bf16* Aa = (const bf16*)(a.ws + WS_A); const float* Dd = (const float*)(a.ws + WS_D);
    float* Y = (float*)(a.ws + WS_Y); bf16* BON = (bf16*)(a.ws + WS_BON);
    const int row0 = b * SEQ;
    LAS float* PAR = (LAS float*)(lds + SCAN_PAR);
    if (tid < 384) { const int k = tid >> 6, c = tid & 63; const float* src = k == 0 ? a.in[11] + R_OFF : (k == 1 ? a.in[11] + K_OFF : (k == 2 ? a.in[11] + V_OFF : (k == 3 ? a.in[17] : (k == 4 ? a.in[18] : a.in[19])))); PAR[tid] = src[h * 64 + c]; }
    __syncthreads();
    const int n16 = lane & 15, q = lane >> 4;
    f32x4 st[4];
#pragma unroll
    for (int jt = 0; jt < 4; ++jt) st[jt] = (f32x4){0.f, 0.f, 0.f, 0.f};
    const bf16* KT = (const bf16*)(a.ws + WS_KT); const float* G16 = (const float*)(a.ws + WS_G16); const float* BS = (const float*)(a.ws + WS_BS);
    struct RawP { u32x4 d0, d1, d2, d3, b0, b1, k0, k1, v0, v1, pv0, pv1; f32x4 g; float bs; } raw;
    const int tt = lane & 15, c0 = (lane >> 4) * 16, ch = h * 64 + c0;
#define P_LOAD(bi) do { const int t_ = (bi) * 64 + (wave - 4) * 16 + tt; const size_t ro_ = (size_t)(row0 + t_) * 512 + ch; \
        const u32x4* d_ = (const u32x4*)(Dd + ro_); raw.d0 = d_[0]; raw.d1 = d_[1]; raw.d2 = d_[2]; raw.d3 = d_[3]; \
        raw.b0 = *(const u32x4*)(Aa + ro_); raw.b1 = *(const u32x4*)(Aa + ro_ + 8); raw.k0 = *(const u32x4*)(KT + ro_); raw.k1 = *(const u32x4*)(KT + ro_ + 8); \
        const bf16* p_ = P + (size_t)(row0 + t_) * RW + V_OFF + ch; raw.v0 = *(const u32x4*)p_; raw.v1 = *(const u32x4*)(p_ + 8); \
        if (t_ > 0) { raw.pv0 = *(const u32x4*)(p_ - RW); raw.pv1 = *(const u32x4*)(p_ - RW + 8); } else { raw.pv0 = raw.pv1 = (u32x4){0u, 0u, 0u, 0u}; } \
        raw.bs = BS[(size_t)(row0 + t_) * 8 + h]; \
        if (lane < 16) raw.g = *(const f32x4*)(G16 + (size_t)((row0 + (bi) * 64 + (wave - 4) * 16) >> 4) * 512 + h * 64 + 4 * lane); } while (0)
    if (wave >= 4) P_LOAD(0);
#pragma unroll 1
    for (int kb = -1; kb < SEQ / 64; ++kb) {
        if (wave >= 4 && kb + 1 < SEQ / 64) {
        LAS unsigned char* cb = lds + (((kb + 1) & 1) * 4 + (wave - 4)) * CH_BYTES;
        {
            const int t = (kb + 1) * 64 + (wave - 4) * 16 + tt, row = row0 + t;
            { const u32x4 dd[4] = {raw.d0, raw.d1, raw.d2, raw.d3};
              u32x4 aw[2], rw[2];
#pragma unroll
              for (int g = 0; g < 4; ++g) { const unsigned a01 = (dd[g].x & 0xffffu) | (dd[g].y << 16), a23 = (dd[g].z & 0xffffu) | (dd[g].w << 16), r01 = (dd[g].x >> 16) | (dd[g].y & 0xffff0000u), r23 = (dd[g].z >> 16) | (dd[g].w & 0xffff0000u);
                  if (g & 1) { aw[g >> 1].z = a01; aw[g >> 1].w = a23; rw[g >> 1].z = r01; rw[g >> 1].w = r23; } else { aw[g >> 1].x = a01; aw[g >> 1].y = a23; rw[g >> 1].x = r01; rw[g >> 1].y = r23; } }
              *(LAS u32x4*)(cb + CH_AT + tt * 128 + SWZ(tt, c0 * 2)) = aw[0]; *(LAS u32x4*)(cb + CH_AT + tt * 128 + SWZ(tt, c0 * 2 + 16)) = aw[1];
              *(LAS u32x4*)(cb + CH_RT + tt * 128 + SWZ(tt, c0 * 2)) = rw[0]; *(LAS u32x4*)(cb + CH_RT + tt * 128 + SWZ(tt, c0 * 2 + 16)) = rw[1]; }
            *(LAS u32x4*)(cb + CH_BKR + tt * 128 + SWZ(tt, c0 * 2)) = raw.b0; *(LAS u32x4*)(cb + CH_BKR + tt * 128 + SWZ(tt, c0 * 2 + 16)) = raw.b1;
            *(LAS u32x4*)(cb + CH_BKR + (16 + tt) * 128 + SWZ(tt, c0 * 2)) = raw.k0; *(LAS u32x4*)(cb + CH_BKR + (16 + tt) * 128 + SWZ(tt, c0 * 2 + 16)) = raw.k1;
            { const unsigned bw[8] = {raw.b0.x, raw.b0.y, raw.b0.z, raw.b0.w, raw.b1.x, raw.b1.y, raw.b1.z, raw.b1.w}, kw[8] = {raw.k0.x, raw.k0.y, raw.k0.z, raw.k0.w, raw.k1.x, raw.k1.y, raw.k1.z, raw.k1.w};
#pragma unroll
              for (int p = 0; p < 8; ++p) {
                  *(LAS bf16*)(cb + CH_BKT + (c0 + 2 * p) * BKT_ROW + tt * 2) = (bf16)(bw[p] & 0xffffu); *(LAS bf16*)(cb + CH_BKT + (c0 + 2 * p + 1) * BKT_ROW + tt * 2) = (bf16)(bw[p] >> 16);
                  *(LAS bf16*)(cb + CH_BKT + (c0 + 2 * p) * BKT_ROW + (16 + tt) * 2) = (bf16)(kw[p] & 0xffffu); *(LAS bf16*)(cb + CH_BKT + (c0 + 2 * p + 1) * BKT_ROW + (16 + tt) * 2) = (bf16)(kw[p] >> 16); } }
#pragma unroll
            for (int hf = 0; hf < 2; ++hf) { float xv[8], pr[8], bo[8]; unpack8(hf ? raw.v1 : raw.v0, xv); unpack8(hf ? raw.pv1 : raw.pv0, pr);
#pragma unroll
              for (int e = 0; e < 8; ++e) { xv[e] += (pr[e] - xv[e]) * PAR[128 + c0 + hf * 8 + e]; bo[e] = raw.bs * xv[e];
                  *(LAS bf16*)(cb + CH_VT + (c0 + hf * 8 + e) * VT_ROW + tt * 2) = (bf16)(pk2c(xv[e], 0.f) & 0xffffu); }
              *(u32x4*)(BON + (size_t)row * 1024 + ch + hf * 8) = pack8f(bo); }
            if (lane < 16) *(LAS f32x4*)(cb + CH_G + lane * 16) = raw.g;
            if (kb + 2 < SEQ / 64) P_LOAD(kb + 2);
        }
        asm volatile("s_waitcnt lgkmcnt(0)" ::: "memory");
        {
            const int r = lane & 31, hh = lane >> 5;
            f32x16 X;
#pragma unroll
            for (int i = 0; i < 16; ++i) X[i] = 0.f;
#pragma unroll
            for (int ks = 0; ks < 4; ++ks) {
                const bf16x8 ga = *(const LAS bf16x8*)(cb + CH_BKR + r * 128 + SWZ(r, (16 * ks + 8 * hh) * 2));
                const bf16x8 gb = *(const LAS bf16x8*)(cb + (r < 16 ? CH_AT + r * 128 : CH_RT + (r - 16) * 128) + SWZ(r, (16 * ks + 8 * hh) * 2));
                X = MFMA32(ga, gb, X);
            }
            LAS float* XM = (LAS float*)(cb + CH_BKR);
            asm volatile("s_waitcnt lgkmcnt(0)" ::: "memory");
#pragma unroll
            for (int i = 0; i < 16; ++i) { const int rowx = crow(i, hh), s_ = rowx & 15, t_ = r & 15; const bool keep = r < 16 ? (s_ < t_) : (s_ <= t_); XM[rowx * 36 + r] = keep ? X[i] : 0.f; }
            asm volatile("s_waitcnt lgkmcnt(0)" ::: "memory");
            const int tcol = lane & 15;
            float x[16];
#pragma unroll
            for (int s_ = 15; s_ >= 0; --s_) {
                float nrow[16];
#pragma unroll
                for (int g = (s_ + 1) >> 2; g < 4; ++g) { const f32x4 v = *(const LAS f32x4*)(XM + s_ * 36 + 4 * g); nrow[4 * g] = v[0]; nrow[4 * g + 1] = v[1]; nrow[4 * g + 2] = v[2]; nrow[4 * g + 3] = v[3]; }
                float acc = 0.f;
#pragma unroll
                for (int s2 = s_ + 1; s2 < 16; ++s2) acc += nrow[s2] * x[s2];
                x[s_] = s_ < tcol ? acc : (s_ == tcol ? 1.0f : 0.f); }
            const int qq = lane >> 4;
            { float o[8];
#pragma unroll
              for (int e = 0; e < 4; ++e) o[e] = qq == 0 ? x[e] : (qq == 1 ? x[4 + e] : (qq == 2 ? x[8 + e] : x[12 + e]));
              o[4] = o[5] = o[6] = o[7] = 0.f;
              *(LAS u32x4*)(cb + CH_OPS + lane * 16) = pack8f(o); }
            { float o[8];
#pragma unroll
              for (int e = 0; e < 8; ++e) o[e] = qq < 2 ? XM[(16 + 8 * qq + e) * 36 + tcol] : 0.f;
              *(LAS u32x4*)(cb + CH_OPS + 1024 + lane * 16) = pack8f(o); }
            { float o[8];
#pragma unroll
              for (int e = 0; e < 4; ++e) { o[e] = XM[(4 * qq + e) * 36 + 16 + tcol]; o[4 + e] = XM[(16 + 4 * qq + e) * 36 + 16 + tcol]; }
              *(LAS u32x4*)(cb + CH_OPS + 2048 + lane * 16) = pack8f(o); }
        }
        }
        if (wave < 4 && kb >= 0) {
            const int icol = wave * 16 + n16;
#pragma unroll 1
            for (int c = 0; c < 4; ++c) {
                const LAS unsigned char* sb = lds + ((kb & 1) * 4 + c) * CH_BYTES;
                u32x2 a0[2], a1[2], r0[2], r1[2], b0[4], b1[4]; f32x4 gs[4];
#pragma unroll
                for (int ks = 0; ks < 2; ++ks) {
                    a0[ks] = *(const LAS u32x2*)(sb + CH_AT + n16 * 128 + SWZ(n16, (32 * ks + 4 * q) * 2)); a1[ks] = *(const LAS u32x2*)(sb + CH_AT + n16 * 128 + SWZ(n16, (32 * ks + 16 + 4 * q) * 2));
                    r0[ks] = *(const LAS u32x2*)(sb + CH_RT + n16 * 128 + SWZ(n16, (32 * ks + 4 * q) * 2)); r1[ks] = *(const LAS u32x2*)(sb + CH_RT + n16 * 128 + SWZ(n16, (32 * ks + 16 + 4 * q) * 2)); }
                u32x4 vw = *(const LAS u32x4*)(sb + CH_VT + icol * VT_ROW + (q & 1) * 16); if (q >= 2) vw = (u32x4){0u, 0u, 0u, 0u};
                const u32x2 v4 = *(const LAS u32x2*)(sb + CH_VT + icol * VT_ROW + 4 * q * 2);
                const bf16x8 nka = *(const LAS bf16x8*)(sb + CH_OPS + 1024 + lane * 16), tm = *(const LAS bf16x8*)(sb + CH_OPS + lane * 16), ny = *(const LAS bf16x8*)(sb + CH_OPS + 2048 + lane * 16);
#pragma unroll
                for (int jt = 0; jt < 4; ++jt) { b0[jt] = *(const LAS u32x2*)(sb + CH_BKT + (16 * jt + n16) * BKT_ROW + 4 * q * 2); b1[jt] = *(const LAS u32x2*)(sb + CH_BKT + (16 * jt + n16) * BKT_ROW + (16 + 4 * q) * 2); }
                bf16x8 sB[2];
#pragma unroll
                for (int ks = 0; ks < 2; ++ks) { u32x4 w; w.x = pk2c(st[2 * ks][0], st[2 * ks][1]); w.y = pk2c(st[2 * ks][2], st[2 * ks][3]); w.z = pk2c(st[2 * ks + 1][0], st[2 * ks + 1][1]); w.w = pk2c(st[2 * ks + 1][2], st[2 * ks + 1][3]); sB[ks] = __builtin_bit_cast(bf16x8, w); }
                f32x4 W = (f32x4){0.f, 0.f, 0.f, 0.f}, Yc = (f32x4){0.f, 0.f, 0.f, 0.f};
                W = MFMA16(nka, __builtin_bit_cast(bf16x8, vw), W);
#pragma unroll
                for (int ks = 0; ks < 2; ++ks) {
                    u32x4 aw; aw.x = a0[ks].x; aw.y = a0[ks].y; aw.z = a1[ks].x; aw.w = a1[ks].y; u32x4 rw; rw.x = r0[ks].x; rw.y = r0[ks].y; rw.z = r1[ks].x; rw.w = r1[ks].y;
                    W = MFMA16(__builtin_bit_cast(bf16x8, aw), sB[ks], W); Yc = MFMA16(__builtin_bit_cast(bf16x8, rw), sB[ks], Yc);
                }
                f32x4 U;
                { u32x4 ww; ww.x = pk2c(W[0], W[1]); ww.y = pk2c(W[2], W[3]); ww.z = 0u; ww.w = 0u;
                  U = MFMA16(tm, __builtin_bit_cast(bf16x8, ww), ((f32x4){0.f, 0.f, 0.f, 0.f})); }
                __builtin_amdgcn_sched_barrier(0);
#pragma unroll
                for (int jt = 0; jt < 4; ++jt) gs[jt] = *(const LAS f32x4*)(sb + CH_G + (16 * jt + 4 * q) * 4);
                bf16x8 uv;
                { u32x4 w; w.x = pk2c(U[0], U[1]); w.y = pk2c(U[2], U[3]); w.z = v4.x; w.w = v4.y; uv = __builtin_bit_cast(bf16x8, w); }
#pragma unroll
                for (int jt = 0; jt < 4; ++jt) {
                    u32x4 bw; bw.x = b0[jt].x; bw.y = b0[jt].y; bw.z = b1[jt].x; bw.w = b1[jt].y;
                    st[jt] = MFMA16(__builtin_bit_cast(bf16x8, bw), uv, st[jt]);
                    st[jt] = st[jt] * gs[jt];
                }
                Yc = MFMA16(ny, uv, Yc);
                float* yp = Y + (size_t)(row0 + kb * 64 + c * 16 + 4 * q) * 512 + h * 64 + icol;
#pragma unroll
                for (int e = 0; e < 4; ++e) yp[(size_t)e * 512] = Yc[e];
            }
        }
        __syncthreads();
    }
    if (wave < 4) { float* so = a.out + O_WP + (size_t)(b * 8 + h) * 4096 + (size_t)(wave * 16 + n16) * 64;
#pragma unroll
        for (int jt = 0; jt < 4; ++jt) *(f32x4*)(so + 16 * jt + 4 * q) = st[jt]; }
}

__device__ __forceinline__ void scan_sample_unit(const Args& a, LAS unsigned char* lds, int b) {
    const int tid = threadIdx.x, lane = tid & 63, wave = tid >> 6;
    const bf16* P = (const bf16*)(a.ws + WS_P); const bf16* Aa = (const bf16*)(a.ws + WS_A); const float* Dd = (const float*)(a.ws + WS_D);
    float* Y = (float*)(a.ws + WS_Y); bf16* BON = (bf16*)(a.ws + WS_BON);
    LAS float* SA = (LAS float*)lds;
    {
        const int tt = tid >> 7, ch = (tid & 127) * 4, row = TP + b * 4 + tt, prow = tt == 0 ? MT + b : row - 1;
        const bf16* p_ = P + (size_t)row * RW + ch; const bf16* q_ = P + (size_t)prow * RW + ch;
        f32x4 xr = unpack4(*(const u32x2*)(p_ + R_OFF)), xk = unpack4(*(const u32x2*)(p_ + K_OFF)), xv = unpack4(*(const u32x2*)(p_ + V_OFF));
        xr = xr + (unpack4(*(const u32x2*)(q_ + R_OFF)) - xr) * *(const f32x4*)(a.in[11] + R_OFF + ch);
        xk = xk + (unpack4(*(const u32x2*)(q_ + K_OFF)) - xk) * *(const f32x4*)(a.in[11] + K_OFF + ch);
        xv = xv + (unpack4(*(const u32x2*)(q_ + V_OFF)) - xv) * *(const f32x4*)(a.in[11] + V_OFF + ch);
        f32x4 av = unpack4(*(const u32x2*)(Aa + (size_t)row * 512 + ch)), dv = *(const f32x4*)(Dd + (size_t)row * 512 + ch);
#pragma unroll
        for (int e = 0; e < 4; ++e) { av[e] = 1.0f / (1.0f + __expf(-av[e])); dv[e] = __expf(-0.60653066f / (1.0f + __expf(-dv[e]))); }
        f32x4 kk = xk * *(const f32x4*)(a.in[17] + ch);
        const float ss = sum16((kk[0] * kk[0] + kk[1] * kk[1]) + (kk[2] * kk[2] + kk[3] * kk[3]));
        kk = kk * (1.0f / fmaxf(sqrtf(ss), 1e-12f));
        const f32x4 kh = xk * (1.0f + (av - 1.0f) * *(const f32x4*)(a.in[18] + ch));
        const f32x4 rk = xr * kh * *(const f32x4*)(a.in[19] + ch);
        const float bs = sum16((rk[0] + rk[1]) + (rk[2] + rk[3]));
        { const f32x4 bo = xv * bs; u32x2 w; w.x = pk2(bo[0], bo[1]); w.y = pk2(bo[2], bo[3]); *(u32x2*)(BON + (size_t)row * 1024 + ch) = w; }
        LAS float* B_ = SA + tt * 512 + ch;
        *(LAS f32x4*)(B_) = -kk; *(LAS f32x4*)(B_ + 2048) = kk * av; *(LAS f32x4*)(B_ + 4096) = dv; *(LAS f32x4*)(B_ + 6144) = kh; *(LAS f32x4*)(B_ + 8192) = xr; *(LAS f32x4*)(B_ + 10240) = xv;
    }
    __syncthreads();
    {
        const int h = wave, i = lane;
        const float* s_in = a.in[4] + (size_t)(b * 8 + h) * 4096 + i * 64; float* s_out = a.out + O_WS + (size_t)(b * 8 + h) * 4096 + i * 64;
        f32x4 s[16];
#pragma unroll
        for (int g = 0; g < 16; ++g) s[g] = *(const f32x4*)(s_in + 4 * g);
#pragma unroll 1
        for (int t = 0; t < DT; ++t) {
            const LAS float* B = SA + t * 512 + h * 64;
            float sa0 = 0.f, sa1 = 0.f;
#pragma unroll
            for (int g = 0; g < 16; g += 2) { const f32x4 a0 = *(const LAS f32x4*)(B + 4 * g), a1 = *(const LAS f32x4*)(B + 4 * g + 4);
                sa0 += (s[g][0] * a0[0] + s[g][1] * a0[1]) + (s[g][2] * a0[2] + s[g][3] * a0[3]); sa1 += (s[g + 1][0] * a1[0] + s[g + 1][1] * a1[1]) + (s[g + 1][2] * a1[2] + s[g + 1][3] * a1[3]); }
            const float sa = sa0 + sa1, v = B[10240 + i];
            float y0 = 0.f, y1 = 0.f;
#pragma unroll
            for (int g = 0; g < 16; ++g) { const f32x4 b4 = *(const LAS f32x4*)(B + 2048 + 4 * g), d4 = *(const LAS f32x4*)(B + 4096 + 4 * g), k4 = *(const LAS f32x4*)(B + 6144 + 4 * g), r4 = *(const LAS f32x4*)(B + 8192 + 4 * g);
                s[g] = s[g] * d4 + b4 * sa + k4 * v;
                const float yy = (s[g][0] * r4[0] + s[g][1] * r4[1]) + (s[g][2] * r4[2] + s[g][3] * r4[3]); if (g & 1) y1 += yy; else y0 += yy; }
            Y[(size_t)(TP + b * 4 + t) * 512 + h * 64 + i] = y0 + y1;
        }
#pragma unroll
        for (int g = 0; g < 16; ++g) *(f32x4*)(s_out + 4 * g) = s[g];
    }
    __syncthreads();
}

__device__ __forceinline__ void phase_post(const Args& a) {
    const float* Y = (const float*)(a.ws + WS_Y); const bf16* BON = (const bf16*)(a.ws + WS_BON); const bf16* Gg = (const bf16*)(a.ws + WS_G); bf16* MIX = (bf16*)(a.ws + WS_MIX);
    for (int idx = blockIdx.x * NTHR + threadIdx.x; idx < MT * 128; idx += gridDim.x * NTHR) {
        const int row = idx >> 7, c = (idx & 127) * 4;
        const f32x4 y = *(const f32x4*)(Y + (size_t)row * 512 + c);
        const float mean = sum16((y[0] + y[1]) + (y[2] + y[3])) * (1.0f / 64.0f);
        const f32x4 dlt = y - mean;
        const float var = sum16((dlt[0] * dlt[0] + dlt[1] * dlt[1]) + (dlt[2] * dlt[2] + dlt[3] * dlt[3])) * (1.0f / 64.0f);
        const f32x4 yn = dlt * rsqrtf(var + GN_EPS) * *(const f32x4*)(a.in[20] + c) + *(const f32x4*)(a.in[21] + c);
        const f32x4 o = (yn + unpack4(*(const u32x2*)(BON + (size_t)row * 1024 + c))) * unpack4(*(const u32x2*)(Gg + (size_t)row * 512 + c));
        u32x2 w; w.x = pk2(o[0], o[1]); w.y = pk2(o[2], o[3]);
        *(u32x2*)(MIX + (size_t)row * 1024 + 512 + c) = w;
    }
}

constexpr int SROWS1 = 768, KSPLIT = 4, KSPLIT4 = 16;
__device__ __forceinline__ void reduce_gemm1(const Args& a) {
    const float* part = (const float*)(a.ws + WS_D); bf16* QKV = (bf16*)(a.ws + WS_QKV); bf16* P = (bf16*)(a.ws + WS_P);
    for (int idx = blockIdx.x * NTHR + threadIdx.x; idx < 640 * 320; idx += gridDim.x * NTHR) {
        const int r = idx / 320, c = (idx - r * 320) * 8;
        f32x4 s0 = (f32x4){0.f, 0.f, 0.f, 0.f}, s1 = s0;
#pragma unroll
        for (int k = 0; k < KSPLIT; ++k) { const float* p = part + ((size_t)k * SROWS1 + r) * 2560 + c; s0 = s0 + *(const f32x4*)p; s1 = s1 + *(const f32x4*)(p + 4); }
        u32x4 w; w.x = pk2(s0[0], s0[1]); w.y = pk2(s0[2], s0[3]); w.z = pk2(s1[0], s1[1]); w.w = pk2(s1[2], s1[3]);
        if (c < 768) *(u32x4*)(QKV + (size_t)(TP + r) * QW + c) = w; else *(u32x4*)(P + (size_t)(TP + r) * RW + (c - 768)) = w;
    }
}
__device__ __forceinline__ void reduce_gemm2(const Args& a) {
    const float* part = (const float*)(a.ws + WS_QKV); bf16* X1G = (bf16*)(a.ws + WS_X1G); float* SSQ = (float*)(a.ws + WS_SSQ);
    const int lane = threadIdx.x & 63;
    for (int r = blockIdx.x * 8 + (threadIdx.x >> 6); r < TS; r += gridDim.x * 8) {
        float ss = 0.f;
#pragma unroll
        for (int i = 0; i < 4; ++i) { const int c = lane * 4 + i * 256;
            f32x4 v = *(const f32x4*)(a.in[1] + (size_t)r * 1024 + c);
#pragma unroll
            for (int k = 0; k < KSPLIT; ++k) v = v + *(const f32x4*)(part + ((size_t)k * TS + r) * 1024 + c);
            *(f32x4*)(a.out + O_YS + (size_t)r * 1024 + c) = v;
            ss += (v[0] * v[0] + v[1] * v[1]) + (v[2] * v[2] + v[3] * v[3]);
            const f32x4 g = *(const f32x4*)(a.in[23] + c); u32x2 w; w.x = pk2(v[0] * g[0], v[1] * g[1]); w.y = pk2(v[2] * g[2], v[3] * g[3]);
            *(u32x2*)(X1G + (size_t)(TP + r) * 1024 + c) = w; }
        ss = wave_sum(ss);
        if (lane == 0) SSQ[TP + r] = ss;
    }
}
__device__ __forceinline__ void reduce_gemm3(const Args& a) {
    const float* part = (const float*)(a.ws + WS_MIX); bf16* U = (bf16*)(a.ws + WS_U); const float* SSQ = (const float*)(a.ws + WS_SSQ);
    for (int idx = blockIdx.x * NTHR + threadIdx.x; idx < TS * 512; idx += gridDim.x * NTHR) {
        const int r = idx >> 9, c = (idx & 511) * 8;
        f32x4 s0 = (f32x4){0.f, 0.f, 0.f, 0.f}, s1 = s0;
#pragma unroll
        for (int k = 0; k < KSPLIT; ++k) { const float* p = part + ((size_t)k * TS + r) * 4096 + c; s0 = s0 + *(const f32x4*)p; s1 = s1 + *(const f32x4*)(p + 4); }
        const float rs = rsqrtf(SSQ[TP + r] * (1.0f / 1024.0f) + RMS_EPS);
#pragma unroll
        for (int e = 0; e < 4; ++e) { const float x = fmaxf(s0[e] * rs, 0.f), y = fmaxf(s1[e] * rs, 0.f); s0[e] = x * x; s1[e] = y * y; }
        u32x4 w; w.x = pk2(s0[0], s0[1]); w.y = pk2(s0[2], s0[3]); w.z = pk2(s1[0], s1[1]); w.w = pk2(s1[2], s1[3]);
        *(u32x4*)(U + (size_t)(TP + r) * 4096 + c) = w;
    }
}
__device__ __forceinline__ void reduce_gemm4(const Args& a) {
    const float* part = (const float*)(a.ws + WS_MIX);
    for (int idx = blockIdx.x * NTHR + threadIdx.x; idx < TS * 256; idx += gridDim.x * NTHR) {
        const int r = idx >> 8, c = (idx & 255) * 4;
        f32x4 v = *(const f32x4*)(a.out + O_YS + (size_t)r * 1024 + c);
#pragma unroll
        for (int k = 0; k < KSPLIT4; ++k) v = v + *(const f32x4*)(part + ((size_t)k * TS + r) * 1024 + c);
        *(f32x4*)(a.out + O_YS + (size_t)r * 1024 + c) = v;
    }
}

constexpr int N_PHASES = 10;
#define XB_TMO      128
#define XB_XCNT(j)  (256  + 64 * (j))
#define XB_XSUB(j)  (1280 + 64 * (j))
#define XB_XGEN(j)  (2304 + 64 * (j))
#define XB_TOP      3328
#define XB_TOPGEN   3392
#define XCD_BAR_WORDS 3456
#define XB_SPIN_CAP (1u << 18)

__device__ __forceinline__ unsigned xb_ld(unsigned* p)              { return __hip_atomic_load(p, __ATOMIC_RELAXED, __HIP_MEMORY_SCOPE_AGENT); }
__device__ __forceinline__ unsigned xb_add(unsigned* p, unsigned v) { return __hip_atomic_fetch_add(p, v, __ATOMIC_RELAXED, __HIP_MEMORY_SCOPE_AGENT); }
__device__ __forceinline__ unsigned xb_xcc_id() { return (unsigned)__builtin_amdgcn_s_getreg((3 << 11) | 20) & 0xFu; }
#define XB_SPIN(cond, bar) do { unsigned _sp = 0; while (cond) { __builtin_amdgcn_s_sleep(1); \
    if ((++_sp & 255u) == 0u) { if (xb_ld(&(bar)[XB_TMO])) break; if (_sp > XB_SPIN_CAP) { atomicAdd(&(bar)[XB_TMO], 1u); break; } } } } while (0)

struct XcdBarrier {
    unsigned* bar; unsigned x;
    volatile LAS unsigned* st;
};

__device__ __forceinline__ XcdBarrier xcd_barrier_post(unsigned* bar, volatile LAS unsigned* st) {
    XcdBarrier b; b.bar = bar; b.x = xb_xcc_id(); b.st = st;
    if (threadIdx.x == 0) (void)xb_add(&bar[XB_XCNT(b.x)], 1u);
    return b;
}
__device__ __forceinline__ void xcd_barrier_complete(unsigned* bar, unsigned x, unsigned& nloc, unsigned& nx) {
    const unsigned G = gridDim.x * gridDim.y * gridDim.z;
    unsigned sum, cnt, mine, sp = 0u;
    for (;;) {
        sum = 0u; cnt = 0u; mine = 0u;
#pragma unroll
        for (unsigned j = 0; j < 16; ++j) { const unsigned c = xb_ld(&bar[XB_XCNT(j)]); sum += c; cnt += (c > 0u) ? 1u : 0u; mine = (j == x) ? c : mine; }
        if (sum == G) break;
        __builtin_amdgcn_s_sleep(1);
        if ((++sp & 255u) == 0u) { if (xb_ld(&bar[XB_TMO])) break; if (sp > XB_SPIN_CAP) { atomicAdd(&bar[XB_TMO], 1u); break; } }
    }
    nloc = mine > 0u ? mine : 1u; nx = cnt > 0u ? cnt : 1u;
}

__device__ __forceinline__ void xcd_barrier(const XcdBarrier& b) {
    asm volatile("s_waitcnt vmcnt(0)" ::: "memory");
    __syncthreads();
    if (threadIdx.x == 0) {
        unsigned* bar = b.bar;
        __builtin_amdgcn_s_waitcnt(0);
        unsigned nloc = b.st[0], nx = b.st[1];
        if (nloc == 0u) { xcd_barrier_complete(bar, b.x, nloc, nx); b.st[0] = nloc; b.st[1] = nx; }
        const unsigned old = xb_add(&bar[XB_XSUB(b.x)], 1u);
        const unsigned gen = old / nloc;
        if (old + 1u == (gen + 1u) * nloc) {
            __builtin_amdgcn_fence(__ATOMIC_RELEASE, "agent");
            asm volatile("s_waitcnt vmcnt(0)" ::: "memory");
            const unsigned og = xb_add(&bar[XB_TOP], 1u);
            const unsigned tg = og / nx;
            if (og + 1u == (tg + 1u) * nx) xb_add(&bar[XB_TOPGEN], 1u);
            else XB_SPIN(xb_ld(&bar[XB_TOPGEN]) == tg, bar);
            __builtin_amdgcn_fence(__ATOMIC_ACQUIRE, "agent");
            xb_add(&bar[XB_XGEN(b.x)], 1u);
            asm volatile("s_waitcnt vmcnt(0)" ::: "memory");
        } else {
            XB_SPIN(xb_ld(&bar[XB_XGEN(b.x)]) == gen, bar);
            __builtin_amdgcn_fence(__ATOMIC_ACQUIRE, "agent");
            asm volatile("s_waitcnt vmcnt(0)" ::: "memory");
        }
    }
    __syncthreads();
}


__device__ __forceinline__ void fast_grid_sync(unsigned* bar, unsigned target) {
    __syncthreads();
    if (threadIdx.x == 0) {
        __builtin_amdgcn_fence(__ATOMIC_RELEASE, "agent");
        __hip_atomic_fetch_add(bar, 1u, __ATOMIC_RELAXED, __HIP_MEMORY_SCOPE_AGENT);
        while (__hip_atomic_load(bar, __ATOMIC_RELAXED, __HIP_MEMORY_SCOPE_AGENT) < target) __builtin_amdgcn_s_sleep(1);
        __builtin_amdgcn_fence(__ATOMIC_ACQUIRE, "agent");
    }
    __syncthreads();
}
__global__ void __launch_bounds__(NTHR, 2) hymba_fwd(Args args) {
    extern __shared__ __attribute__((aligned(16))) unsigned char lds_raw[];
    LAS unsigned char* lds = (LAS unsigned char*)lds_raw;
    cg::grid_group grid = cg::this_grid();
    const int G = gridDim.x, bx = blockIdx.x;
    const int vcu = (G % 8 == 0) ? (bx % 8) * (G / 8) + bx / 8 : bx;
    unsigned char* ws = args.ws;
#ifndef PH_MASK
#define PH_MASK 0x3ff
#endif
#define PHON(k) (((PH_MASK >> (k)) & 1) && lo <= (k) && (k) < hi)
#ifndef PH_TWICE
#define PH_TWICE 0
#endif
#define PHREP(k) for (int rep_ = 0; rep_ < 1 + ((PH_TWICE >> (k)) & 1); ++rep_, (rep_ < 1 + ((PH_TWICE >> (k)) & 1) ? grid.sync() : (void)0))
#define PHSYNC(k) do { if ((k) + 1 < hi && lo <= (k)) { if ((k) == 0) { grid.sync(); xbar = xcd_barrier_post(bar, xst); } else xcd_barrier(xbar); } } while (0)
    const int lo = args.ph_lo, hi = args.ph_hi;
#define INBAR() do { if (hi - lo > 1) xcd_barrier(xbar); } while (0)
    unsigned* bar = (unsigned*)(ws + WS_BAR); unsigned nbar = 0u;
    if (lo == 0 && bx == 0) for (int w_ = threadIdx.x; w_ < XCD_BAR_WORDS; w_ += NTHR) __hip_atomic_store(bar + w_, 0u, __ATOMIC_RELAXED, __HIP_MEMORY_SCOPE_AGENT);
    volatile LAS unsigned* xst = (volatile LAS unsigned*)(lds + LDS_BYTES - 16);
    if (threadIdx.x < 2) xst[threadIdx.x] = 0u;
    __syncthreads();
    XcdBarrier xbar; xbar.bar = bar; xbar.x = 0; xbar.st = xst;
    if (PHON(0)) PHREP(0) phase0(args, lds);
    PHSYNC(0);
    if (PHON(1)) PHREP(1) { { pg8::Gemm g{(const pg8::bf16_t*)(ws + WS_HN), (const pg8::bf16_t*)(ws + WS_WIN), TP, 2560, 1024, 1024}; pg8::StaticOrder S; S.init(g.M, g.N, G, bx);
          pg8::EpiProj E{(pg8::bf16_t*)(ws + WS_QKV), (pg8::bf16_t*)(ws + WS_P)}; pg8::gemm_phase<pg8::EpiProj, pg8::StaticOrder, true, true>(lds, g, S, E); }
        { pg8::Gemm g{(const pg8::bf16_t*)(ws + WS_HN) + (size_t)TP * 1024, (const pg8::bf16_t*)(ws + WS_WIN), SROWS1, 2560, 1024, 1024 / KSPLIT}; pg8::SplitKOrder S; S.init(g.M, g.N, g.K, g.kloop, G, bx);
          pg8::EpiPartial E{(float*)(ws + WS_D), SROWS1, 2560, g.kloop * 2}; pg8::gemm_phase<pg8::EpiPartial, pg8::SplitKOrder, true, true>(lds, g, S, E); }
        INBAR(); reduce_gemm1(args); }
    PHSYNC(1);
    if (PHON(2)) PHREP(2) { phase_lora_in(args); }
    PHSYNC(2);
    if (PHON(3)) PHREP(3) { pg8::Gemm g{(const pg8::bf16_t*)(ws + WS_L), (const pg8::bf16_t*)(ws + WS_WL), MT, 1536, 256, 256}; pg8::StaticOrder S; S.init(g.M, g.N, G, bx);
        pg8::EpiLora E{(float*)(ws + WS_D), (pg8::bf16_t*)(ws + WS_A), (pg8::bf16_t*)(ws + WS_G), args.in[12], args.in[14]}; pg8::gemm_phase<pg8::EpiLora, pg8::StaticOrder, true, true>(lds, g, S, E); }
    PHSYNC(3);
    if (PHON(4)) PHREP(4) phase_prepass(args);
    PHSYNC(4);
    if (PHON(5)) PHREP(5) {
#ifndef PROBE_PROMPT2
#define PROBE_PROMPT2 1
#endif
        for (int u = bx; u < 128; u += G) scan_mfma_unit(args, lds, u >> 3, u & 7);
        { const int nb = G > 128 ? G - 128 : G, sb = G > 128 ? bx - 128 : bx;
          if (sb >= 0) { for (int u = sb; u < DB; u += nb) scan_sample_unit(args, lds, u);
              for (int u = sb; u < 512; u += nb) attn_prompt_unit(args, lds, u);
              for (int u = sb; u < 256; u += nb) attn_sample_unit(args, lds, u); } } }
    PHSYNC(5);
    if (PHON(6)) PHREP(6) phase_post(args);
    PHSYNC(6);
    if (PHON(7)) PHREP(7) { { pg8::Gemm g{(const pg8::bf16_t*)(ws + WS_MIX), (const pg8::bf16_t*)(ws + WS_WOUT), TP, 1024, 1024, 1024}; pg8::StaticOrder S; S.init(g.M, g.N, G, bx);
          pg8::EpiOut E{args.in[0], args.in[1], TP, args.out, (pg8::bf16_t*)(ws + WS_X1G), args.in[23], (float*)(ws + WS_SSQ)}; pg8::gemm_phase<pg8::EpiOut, pg8::StaticOrder, true, true>(lds, g, S, E); }
        { pg8::Gemm g{(const pg8::bf16_t*)(ws + WS_MIX) + (size_t)TP * 1024, (const pg8::bf16_t*)(ws + WS_WOUT), TS, 1024, 1024, 1024 / KSPLIT}; pg8::SplitKOrder S; S.init(g.M, g.N, g.K, g.kloop, G, bx);
          pg8::EpiPartial E{(float*)(ws + WS_QKV), TS, 1024, g.kloop * 2}; pg8::gemm_phase<pg8::EpiPartial, pg8::SplitKOrder, true, true>(lds, g, S, E); }
        INBAR(); reduce_gemm2(args); }
    PHSYNC(7);
    if (PHON(8)) PHREP(8) { { pg8::Gemm g{(const pg8::bf16_t*)(ws + WS_X1G), (const pg8::bf16_t*)(ws + WS_WUP), TP, 4096, 1024, 1024}; pg8::StaticOrder S; S.init(g.M, g.N, G, bx);
          pg8::EpiUp E{(pg8::bf16_t*)(ws + WS_U), (const float*)(ws + WS_SSQ)}; pg8::gemm_phase<pg8::EpiUp, pg8::StaticOrder, true, true>(lds, g, S, E); }
        { pg8::Gemm g{(const pg8::bf16_t*)(ws + WS_X1G) + (size_t)TP * 1024, (const pg8::bf16_t*)(ws + WS_WUP), TS, 4096, 1024, 1024 / KSPLIT}; pg8::SplitKOrder S; S.init(g.M, g.N, g.K, g.kloop, G, bx);
          pg8::EpiPartial E{(float*)(ws + WS_MIX), TS, 4096, g.kloop * 2}; pg8::gemm_phase<pg8::EpiPartial, pg8::SplitKOrder, true, true>(lds, g, S, E); }
        INBAR(); reduce_gemm3(args); }
    PHSYNC(8);
    if (PHON(9)) PHREP(9) { { pg8::Gemm g{(const pg8::bf16_t*)(ws + WS_U), (const pg8::bf16_t*)(ws + WS_WDN), TP, 1024, 4096, 4096}; pg8::StaticOrder S; S.init(g.M, g.N, G, bx);
          pg8::EpiDown E{args.out}; pg8::gemm_phase<pg8::EpiDown, pg8::StaticOrder, true, true>(lds, g, S, E); }
        { pg8::Gemm g{(const pg8::bf16_t*)(ws + WS_U) + (size_t)TP * 4096, (const pg8::bf16_t*)(ws + WS_WDN), TS, 1024, 4096, 4096 / KSPLIT4}; pg8::SplitKOrder S; S.init(g.M, g.N, g.K, g.kloop, G, bx);
          pg8::EpiPartial E{(float*)(ws + WS_MIX), TS, 1024, g.kloop * 2}; pg8::gemm_phase<pg8::EpiPartial, pg8::SplitKOrder, true, true>(lds, g, S, E); }
        INBAR(); reduce_gemm4(args); }
    (void)vcu;
}

#ifndef MK_PER_PHASE
#define MK_PER_PHASE 0
#endif
extern "C" void kernel_launch(void* const* d_in, const int* in_sizes, int n_in, void* d_out, int out_size, void* d_ws, size_t ws_size, hipStream_t stream) {
    static int grid = 0;
    if (grid == 0) {
        if (n_in != 26 || (size_t)out_size != O_END || ws_size < WS_END) { fprintf(stderr, "kernel_launch: unexpected sizes n_in %d out %d ws %zu (need %zu)\n", n_in, out_size, ws_size, (size_t)WS_END); grid = -1; return; }
        int dev = 0, cus = 0, per_cu = 0;
        hipGetDevice(&dev); hipDeviceGetAttribute(&cus, hipDeviceAttributeMultiprocessorCount, dev);
        if (hipFuncSetAttribute((const void*)hymba_fwd, hipFuncAttributeMaxDynamicSharedMemorySize, LDS_BYTES) != hipSuccess) { fprintf(stderr, "kernel_launch: hipFuncSetAttribute failed\n"); grid = -1; return; }
        if (hipOccupancyMaxActiveBlocksPerMultiprocessor(&per_cu, (const void*)hymba_fwd, NTHR, LDS_BYTES) != hipSuccess || per_cu < 1) { fprintf(stderr, "kernel_launch: occupancy query failed (%d)\n", per_cu); per_cu = 1; }
        (void)hipGetLastError();
        grid = cus * (per_cu > 1 ? 1 : per_cu);
        fprintf(stderr, "kernel_launch: cus %d per_cu %d grid %d\n", cus, per_cu, grid);
    }
    if (grid < 0) return;
    Args a{};
    for (int i = 0; i < 26; ++i) a.in[i] = (const float*)d_in[i];
    a.out = (float*)d_out; a.ws = (unsigned char*)d_ws;
#if MK_PER_PHASE
    for (int ph = 0; ph < N_PHASES; ++ph) { a.ph_lo = ph; a.ph_hi = ph + 1; hipLaunchKernelGGL(hymba_fwd, dim3(grid), dim3(NTHR), LDS_BYTES, stream, a); }
#else
    a.ph_lo = 0; a.ph_hi = N_PHASES;
    void* kargs[] = {&a};
    hipError_t e = hipLaunchCooperativeKernel((const void*)hymba_fwd, dim3(grid), dim3(NTHR), kargs, LDS_BYTES, stream);
    if (e != hipSuccess) fprintf(stderr, "kernel_launch: cooperative launch failed: %s (grid %d)\n", hipGetErrorString(e), grid);
#endif
}
```

```cpp
#include <hip/hip_runtime.h>
#include <hip/hip_cooperative_groups.h>
#include <cstdio>
#include <cstdint>
#include <cmath>
namespace cg = cooperative_groups;
namespace pg8 {
#define PG8_LAS __attribute__((address_space(3)))
typedef unsigned short bf16_t;
typedef short bf16x8 __attribute__((ext_vector_type(8)));
typedef float f32x4 __attribute__((ext_vector_type(4)));
typedef unsigned u32x4 __attribute__((ext_vector_type(4)));
constexpr int BM = 256, BK = 64, HALF = 128, HTB = HALF * BK * 2  , STAGE_BYTES = 8 * HTB, NXCD = 8, WGM = 8;

__host__ __device__ __forceinline__ int lds_byte(int r, int c) { const int st = (r >> 4) * 2 + (c >> 5), rr = r & 15, cc = c & 31, ob = rr * 64 + cc * 2; return st * 1024 + (ob ^ (((ob >> 9) & 1) << 5)); }
__host__ __device__ __forceinline__ void stage_rc(int b, int& R, int& C) { const int st = b / 1024, sb = b % 1024, swz = sb ^ (((sb >> 9) & 1) << 5); R = (st >> 1) * 16 + swz / 64; C = (st & 1) * 32 + (swz % 64) / 2; }
__host__ __device__ __forceinline__ int perm32(int rho) { const int n = rho >> 4, i = rho & 15; return 8 * (i >> 2) + 4 * n + (i & 3); }

struct Unit { int pm, pn, kb; };
struct Gemm { const bf16_t* A; const bf16_t* Bt; int M, N, K, kloop; };

struct StaticOrder {
    int nM, nN, nwg, G, c;
    __host__ __device__ void init(int M, int N, int G_, int c_) { nM = M / BM; nN = N / BM; nwg = nM * nN; G = G_; c = c_; }
    __host__ __device__ bool next(int i, Unit& u) const {
        const long L = (long)i * G + c; if (L >= nwg) return false;
        int wgid = (int)L; { const int q = nwg / NXCD, r = nwg % NXCD, xcd = wgid % NXCD, off = wgid / NXCD; wgid = (xcd < r ? xcd * (q + 1) : r * (q + 1) + (xcd - r) * q) + off; }
        const int nig = WGM * nN, gid = wgid / nig, fm = gid * WGM, gsz = (nM - fm) < WGM ? (nM - fm) : WGM;
        u.pm = fm + ((wgid % nig) % gsz); u.pn = (wgid % nig) / gsz; u.kb = 0; return true;
    }
    __device__ __forceinline__ void a_ready(const Unit&) const {}
    __device__ __forceinline__ void done(const Unit&) const {}
};
struct SplitKOrder {
    int nM, nN, nK, nwg, G, c, kbytes;
    __host__ __device__ void init(int M, int N, int K, int kloop, int G_, int c_) { nM = M / BM; nN = N / BM; nK = K / kloop; nwg = nM * nN * nK; G = G_; c = c_; kbytes = kloop * 2; }
    __host__ __device__ bool next(int i, Unit& u) const {
        const long L = (long)i * G + c; if (L >= nwg) return false;
        const int kc = (int)L % nK, rest = (int)L / nK; u.pn = rest % nN; u.pm = rest / nN; u.kb = kc * kbytes; return true;
    }
    __device__ __forceinline__ void a_ready(const Unit&) const {}
    __device__ __forceinline__ void done(const Unit&) const {}
};

__device__ __forceinline__ unsigned cvt_pk_bf16(float lo, float hi) { unsigned r; asm volatile("v_cvt_pk_bf16_f32 %0, %1, %2" : "=v"(r) : "v"(lo), "v"(hi)); return r; }
__device__ __forceinline__ u32x4 pack8(const f32x4 v0, const f32x4 v1) { u32x4 w; w.x = cvt_pk_bf16(v0[0], v0[1]); w.y = cvt_pk_bf16(v0[2], v0[3]); w.z = cvt_pk_bf16(v1[0], v1[1]); w.w = cvt_pk_bf16(v1[2], v1[3]); return w; }

struct EpiProj {
    static constexpr bool PERM = true, AFTER_DRAIN = false;
    bf16_t* QKV; bf16_t* P;
    __device__ __forceinline__ void operator()(const f32x4 (&acc)[2][2][4][2], const Unit& u, int wr, int wc, int fr, int fq) const {
        const int row0 = u.pm * BM + wr * 64 + fr;
        bf16_t* base; int ldc, colt;
        if (u.pn < 3) { base = QKV; ldc = 768; colt = u.pn * BM; } else { base = P; ldc = 1792; colt = (u.pn - 3) * BM; }
        const int col0 = colt + wc * 32 + 8 * fq;
#pragma unroll
        for (int ai = 0; ai < 2; ++ai)
#pragma unroll
            for (int m = 0; m < 4; ++m) { bf16_t* rowp = base + (size_t)(row0 + ai * HALF + m * 16) * ldc + col0;
#pragma unroll
                for (int bj = 0; bj < 2; ++bj) *(u32x4*)(rowp + bj * HALF) = pack8(acc[ai][bj][m][0], acc[ai][bj][m][1]); }
    }
};

struct EpiLora {
    static constexpr bool PERM = true, AFTER_DRAIN = false;
    float* Dd; bf16_t* Aa; bf16_t* Gg; const float* w0; const float* a0;
    __device__ __forceinline__ void operator()(const f32x4 (&acc)[2][2][4][2], const Unit& u, int wr, int wc, int fr, int fq) const {
        const int row0 = u.pm * BM + wr * 64 + fr;
        const int kind = u.pn >> 1;
        const int col0 = (u.pn & 1) * BM + wc * 32 + 8 * fq;
        if (kind == 0) {
            f32x4 bv[2][2];
#pragma unroll
            for (int bj = 0; bj < 2; ++bj)
#pragma unroll
                for (int n = 0; n < 2; ++n) bv[bj][n] = *(const f32x4*)(w0 + col0 + bj * HALF + 4 * n);
#pragma unroll
            for (int ai = 0; ai < 2; ++ai)
#pragma unroll
                for (int m = 0; m < 4; ++m) { float* rp = Dd + (size_t)(row0 + ai * HALF + m * 16) * 512 + col0;
#pragma unroll
                    for (int bj = 0; bj < 2; ++bj)
#pragma unroll
                        for (int n = 0; n < 2; ++n) { f32x4 v = acc[ai][bj][m][n] + bv[bj][n];
                            *(f32x4*)(rp + bj * HALF + 4 * n) = v; } }
        } else if (kind == 1) {
            f32x4 bv[2][2];
#pragma unroll
            for (int bj = 0; bj < 2; ++bj)
#pragma unroll
                for (int n = 0; n < 2; ++n) bv[bj][n] = *(const f32x4*)(a0 + col0 + bj * HALF + 4 * n);
#pragma unroll
            for (int ai = 0; ai < 2; ++ai)
#pragma unroll
                for (int m = 0; m < 4; ++m) { bf16_t* rp = Aa + (size_t)(row0 + ai * HALF + m * 16) * 512 + col0;
#pragma unroll
                    for (int bj = 0; bj < 2; ++bj) { f32x4 v0 = acc[ai][bj][m][0] + bv[bj][0], v1 = acc[ai][bj][m][1] + bv[bj][1];
                        *(u32x4*)(rp + bj * HALF) = pack8(v0, v1); } }
        } else {
#pragma unroll
            for (int ai = 0; ai < 2; ++ai)
#pragma unroll
                for (int m = 0; m < 4; ++m) { bf16_t* rp = Gg + (size_t)(row0 + ai * HALF + m * 16) * 512 + col0;
#pragma unroll
                    for (int bj = 0; bj < 2; ++bj) *(u32x4*)(rp + bj * HALF) = pack8(acc[ai][bj][m][0], acc[ai][bj][m][1]); }
        }
    }
};

struct EpiOut {
    static constexpr bool PERM = true, AFTER_DRAIN = false;
    const float* xp; const float* xs; int TPr; float* out; bf16_t* X1G; const float* g2; float* SSQ;
    __device__ __forceinline__ void operator()(const f32x4 (&acc)[2][2][4][2], const Unit& u, int wr, int wc, int fr, int fq) const {
        const int row0 = u.pm * BM + wr * 64 + fr;
        const int col0 = u.pn * BM + wc * 32 + 8 * fq;
        f32x4 gv[2][2];
#pragma unroll
        for (int bj = 0; bj < 2; ++bj)
#pragma unroll
            for (int n = 0; n < 2; ++n) gv[bj][n] = *(const f32x4*)(g2 + col0 + bj * HALF + 4 * n);
#pragma unroll
        for (int ai = 0; ai < 2; ++ai)
#pragma unroll
            for (int m = 0; m < 4; ++m) { const int row = row0 + ai * HALF + m * 16;
                const float* xr = (row < TPr ? xp + (size_t)row * 1024 : xs + (size_t)(row - TPr) * 1024) + col0;
                float* orow = out + (size_t)row * 1024 + col0; bf16_t* grow = X1G + (size_t)row * 1024 + col0;
                float ss = 0.f;
#pragma unroll
                for (int bj = 0; bj < 2; ++bj) {
                    const f32x4 v0 = acc[ai][bj][m][0] + *(const f32x4*)(xr + bj * HALF), v1 = acc[ai][bj][m][1] + *(const f32x4*)(xr + bj * HALF + 4);
                    *(f32x4*)(orow + bj * HALF) = v0; *(f32x4*)(orow + bj * HALF + 4) = v1;
                    ss += (v0[0] * v0[0] + v0[1] * v0[1]) + (v0[2] * v0[2] + v0[3] * v0[3]) + (v1[0] * v1[0] + v1[1] * v1[1]) + (v1[2] * v1[2] + v1[3] * v1[3]);
                    *(u32x4*)(grow + bj * HALF) = pack8(v0 * gv[bj][0], v1 * gv[bj][1]);
                }
                ss += __shfl_xor(ss, 16); ss += __shfl_xor(ss, 32);
                if (fq == 0) atomicAdd(SSQ + row, ss);
            }
    }
};

struct EpiUp {
    static constexpr bool PERM = true, AFTER_DRAIN = false;
    bf16_t* U; const float* SSQ;
    __device__ __forceinline__ void operator()(const f32x4 (&acc)[2][2][4][2], const Unit& u, int wr, int wc, int fr, int fq) const {
        const int row0 = u.pm * BM + wr * 64 + fr;
        const int col0 = u.pn * BM + wc * 32 + 8 * fq;
#pragma unroll
        for (int ai = 0; ai < 2; ++ai)
#pragma unroll
            for (int m = 0; m < 4; ++m) { const int row = row0 + ai * HALF + m * 16;
                const float rs = rsqrtf(SSQ[row] * (1.0f / 1024.0f) + 1e-6f);
                bf16_t* rowp = U + (size_t)row * 4096 + col0;
#pragma unroll
                for (int bj = 0; bj < 2; ++bj) {
                    f32x4 v0 = acc[ai][bj][m][0] * rs, v1 = acc[ai][bj][m][1] * rs;
#pragma unroll
                    for (int e = 0; e < 4; ++e) { const float a = fmaxf(v0[e], 0.f), b = fmaxf(v1[e], 0.f); v0[e] = a * a; v1[e] = b * b; }
                    *(u32x4*)(rowp + bj * HALF) = pack8(v0, v1);
                } }
    }
};

struct EpiDown {
    static constexpr bool PERM = true, AFTER_DRAIN = false;
    float* out;
    __device__ __forceinline__ void operator()(const f32x4 (&acc)[2][2][4][2], const Unit& u, int wr, int wc, int fr, int fq) const {
        const int row0 = u.pm * BM + wr * 64 + fr;
        const int col0 = u.pn * BM + wc * 32 + 8 * fq;
#pragma unroll
        for (int ai = 0; ai < 2; ++ai)
#pragma unroll
            for (int m = 0; m < 4; ++m) { float* orow = out + (size_t)(row0 + ai * HALF + m * 16) * 1024 + col0;
#pragma unroll
                for (int bj = 0; bj < 2; ++bj) {
                    const f32x4 v0 = acc[ai][bj][m][0] + *(const f32x4*)(orow + bj * HALF), v1 = acc[ai][bj][m][1] + *(const f32x4*)(orow + bj * HALF + 4);
                    *(f32x4*)(orow + bj * HALF) = v0; *(f32x4*)(orow + bj * HALF + 4) = v1;
                } }
    }
};

struct EpiDownAtomic {
    static constexpr bool PERM = true, AFTER_DRAIN = false;
    float* out;
    __device__ __forceinline__ void operator()(const f32x4 (&acc)[2][2][4][2], const Unit& u, int wr, int wc, int fr, int fq) const {
        const int row0 = u.pm * BM + wr * 64 + fr;
        const int col0 = u.pn * BM + wc * 32 + 8 * fq;
#pragma unroll
        for (int ai = 0; ai < 2; ++ai)
#pragma unroll
            for (int m = 0; m < 4; ++m) { float* orow = out + (size_t)(row0 + ai * HALF + m * 16) * 1024 + col0;
#pragma unroll
                for (int bj = 0; bj < 2; ++bj)
#pragma unroll
                    for (int n = 0; n < 2; ++n)
#pragma unroll
                        for (int e2 = 0; e2 < 4; ++e2) atomicAdd(orow + bj * HALF + 4 * n + e2, acc[ai][bj][m][n][e2]); }
    }
};

struct EpiPartial {
    static constexpr bool PERM = true, AFTER_DRAIN = false;
    float* part; int mrows, ldc, kbytes;
    __device__ __forceinline__ void operator()(const f32x4 (&acc)[2][2][4][2], const Unit& u, int wr, int wc, int fr, int fq) const {
        const int row0 = u.pm * BM + wr * 64 + fr, col0 = u.pn * BM + wc * 32 + 8 * fq, kc = u.kb / kbytes;
        float* base = part + (size_t)kc * mrows * ldc;
#pragma unroll
        for (int ai = 0; ai < 2; ++ai)
#pragma unroll
            for (int m = 0; m < 4; ++m) { float* orow = base + (size_t)(row0 + ai * HALF + m * 16) * ldc + col0;
#pragma unroll
                for (int bj = 0; bj < 2; ++bj) { *(f32x4*)(orow + bj * HALF) = acc[ai][bj][m][0]; *(f32x4*)(orow + bj * HALF + 4) = acc[ai][bj][m][1]; } }
    }
};

template <class Epi, class Sched, bool ALIGN_EPI = false, bool SP2 = false>
__device__ __forceinline__ void gemm_phase(PG8_LAS unsigned char* lds, const Gemm g, const Sched& S, const Epi& E) {
    const int tid = threadIdx.x, wid = __builtin_amdgcn_readfirstlane(tid >> 6), lane = tid & 63, wr = wid >> 2, wc = wid & 3, fr = lane & 15, fq = lane >> 4;
    const int K = g.K, nt = g.kloop / BK;
    unsigned voffA[2], voffB[2];
#pragma unroll
    for (int i = 0; i < 2; ++i) { int R, C; stage_rc(tid * 16 + i * 8192, R, C); const int Rb = Epi::PERM ? ((R & ~31) + perm32(R & 31)) : R;
        voffA[i] = (unsigned)(R * K + C) * 2u; voffB[i] = (unsigned)(Rb * K + C) * 2u; }
    const size_t kstep = (size_t)(BK * 2);
    const size_t hstep = (size_t)HALF * K * 2;
    const size_t tstep = 2 * hstep;
    const unsigned ldsw = (unsigned)wid * 1024u;
    const int aoff = lds_byte(wr * 64 + fr, fq * 8), boff = lds_byte(wc * 32 + fr, fq * 8);
#define PG8_SA(b, h) (((b) * 2 + (h)) * HTB)
#define PG8_SB(b, h) ((4 + (b) * 2 + (h)) * HTB)
#define PG8_STAGE(bufoff, gbase, voff) do { _Pragma("unroll") for (int _i = 0; _i < 2; ++_i) \
        __builtin_amdgcn_global_load_lds((const unsigned*)((const char*)(gbase) + (voff)[_i]), (PG8_LAS unsigned*)(lds + (bufoff) + ldsw + _i * 8192), 16, 0, 0); } while (0)
#define PG8_LDA(dst, b, h) do { _Pragma("unroll") for (int m = 0; m < 4; ++m) _Pragma("unroll") for (int k = 0; k < 2; ++k) dst[m][k] = *(const PG8_LAS bf16x8*)(lds + PG8_SA(b, h) + aoff + m * 2048 + k * 1024); } while (0)
#define PG8_LDB(dst, b, h) do { _Pragma("unroll") for (int n = 0; n < 2; ++n) _Pragma("unroll") for (int k = 0; k < 2; ++k) dst[n][k] = *(const PG8_LAS bf16x8*)(lds + PG8_SB(b, h) + boff + n * 2048 + k * 1024); } while (0)
#define PG8_MMA(ai, bj, At, Bt) do { __builtin_amdgcn_s_setprio(1); _Pragma("unroll") for (int m = 0; m < 4; ++m) _Pragma("unroll") for (int n = 0; n < 2; ++n) _Pragma("unroll") for (int k = 0; k < 2; ++k) \
        acc[ai][bj][m][n] = __builtin_amdgcn_mfma_f32_16x16x32_bf16(Bt[n][k], At[m][k], acc[ai][bj][m][n], 0, 0, 0); __builtin_amdgcn_s_setprio(0); } while (0)
#define PG8_WAIT_V(n) asm volatile("s_waitcnt vmcnt(" #n ")" ::: "memory")
#define PG8_WAIT_L(n) asm volatile("s_waitcnt lgkmcnt(" #n ")" ::: "memory")
#define PG8_BAR __builtin_amdgcn_s_barrier()
#define PG8_SCHED __builtin_amdgcn_sched_barrier(0)
    Unit cur, nxt; int ui = 0;
    if (!S.next(0, cur)) return;
    f32x4 acc[2][2][4][2];
#pragma unroll
    for (int a = 0; a < 2; ++a)
#pragma unroll
        for (int b = 0; b < 2; ++b)
#pragma unroll
            for (int m = 0; m < 4; ++m)
#pragma unroll
                for (int n = 0; n < 2; ++n) acc[a][b][m][n] = (f32x4){0.f, 0.f, 0.f, 0.f};
    bf16x8 At[4][2], B0[2][2], B1[2][2];
    const char* cA = (const char*)g.A + (size_t)cur.pm * tstep + cur.kb; const char* cB = (const char*)g.Bt + (size_t)cur.pn * tstep + cur.kb;
    S.a_ready(cur);
    if constexpr (SP2) {
        PG8_STAGE(PG8_SB(0, 0), cB, voffB); PG8_STAGE(PG8_SB(0, 1), cB + hstep, voffB); PG8_STAGE(PG8_SA(0, 0), cA, voffA); PG8_STAGE(PG8_SA(0, 1), cA + hstep, voffA);
        if (wr == 1) PG8_BAR;
        PG8_WAIT_V(2); PG8_BAR;
        PG8_STAGE(PG8_SB(1, 0), cB + kstep, voffB); PG8_STAGE(PG8_SA(1, 0), cA + kstep, voffA); PG8_STAGE(PG8_SB(1, 1), cB + hstep + kstep, voffB);
        PG8_WAIT_V(6); PG8_BAR;
    } else {
        PG8_STAGE(PG8_SB(0, 0), cB, voffB); PG8_STAGE(PG8_SA(0, 0), cA, voffA); PG8_STAGE(PG8_SB(0, 1), cB + hstep, voffB); PG8_STAGE(PG8_SA(0, 1), cA + hstep, voffA);
        if (wr == 1) PG8_BAR;
        PG8_WAIT_V(4); PG8_BAR;
        PG8_STAGE(PG8_SB(1, 0), cB + kstep, voffB); PG8_STAGE(PG8_SA(1, 0), cA + kstep, voffA); PG8_STAGE(PG8_SB(1, 1), cB + hstep + kstep, voffB);
        PG8_WAIT_V(6); PG8_BAR;
    }
    for (;;) {
        const bool has_next = S.next(ui + 1, nxt);
        const char* nA = has_next ? (const char*)g.A + (size_t)nxt.pm * tstep + nxt.kb : cA; const char* nB = has_next ? (const char*)g.Bt + (size_t)nxt.pn * tstep + nxt.kb : cB;
#pragma unroll 1
        for (int t = 0; t < nt; t += 2) {
            const bool last = (t == nt - 2);
            const char* a1 = cA + (size_t)(t + 1) * kstep;
            const char* a2 = last ? nA : cA + (size_t)(t + 2) * kstep; const char* b2 = last ? nB : cB + (size_t)(t + 2) * kstep;
            const char* a3 = a2 + kstep; const char* b3 = b2 + kstep;
            if (last && has_next) S.a_ready(nxt);
            if constexpr (SP2) {
            PG8_LDB(B0, 0, 0); PG8_LDB(B1, 0, 1); PG8_SCHED; PG8_LDA(At, 0, 0); PG8_STAGE(PG8_SA(1, 1), a1 + hstep, voffA);
            PG8_WAIT_V(8); PG8_WAIT_L(0); PG8_BAR; PG8_MMA(0, 0, At, B0); PG8_MMA(0, 1, At, B1); PG8_BAR; PG8_SCHED;
            PG8_LDA(At, 0, 1); PG8_STAGE(PG8_SB(0, 0), b2, voffB); PG8_STAGE(PG8_SB(0, 1), b2 + hstep, voffB); PG8_STAGE(PG8_SA(0, 0), a2, voffA);
            PG8_WAIT_V(8); PG8_WAIT_L(0); PG8_BAR; PG8_MMA(1, 0, At, B0); PG8_MMA(1, 1, At, B1); PG8_BAR; PG8_SCHED;
            PG8_LDB(B0, 1, 0); PG8_LDB(B1, 1, 1); PG8_SCHED; PG8_LDA(At, 1, 0); PG8_STAGE(PG8_SA(0, 1), a2 + hstep, voffA);
            PG8_WAIT_V(8); PG8_WAIT_L(0); PG8_BAR; PG8_MMA(0, 0, At, B0); PG8_MMA(0, 1, At, B1); PG8_BAR; PG8_SCHED;
            PG8_LDA(At, 1, 1); PG8_STAGE(PG8_SB(1, 0), b3, voffB); PG8_STAGE(PG8_SB(1, 1), b3 + hstep, voffB); PG8_STAGE(PG8_SA(1, 0), a3, voffA);
            PG8_WAIT_V(8); PG8_WAIT_L(0); PG8_BAR; PG8_MMA(1, 0, At, B0); PG8_MMA(1, 1, At, B1); PG8_BAR; PG8_SCHED;
            } else {
            PG8_LDB(B0, 0, 0); PG8_SCHED; PG8_LDA(At, 0, 0); PG8_STAGE(PG8_SA(1, 1), a1 + hstep, voffA);
            PG8_WAIT_L(8); PG8_BAR; PG8_WAIT_L(0); PG8_MMA(0, 0, At, B0); PG8_BAR; PG8_SCHED;
            PG8_LDB(B1, 0, 1); PG8_STAGE(PG8_SB(0, 0), b2, voffB);
            PG8_BAR; PG8_WAIT_L(0); PG8_MMA(0, 1, At, B1); PG8_BAR;
            PG8_LDA(At, 0, 1); PG8_STAGE(PG8_SA(0, 0), a2, voffA);
            PG8_BAR; PG8_WAIT_L(0); PG8_MMA(1, 0, At, B0); PG8_BAR; PG8_SCHED;
            PG8_STAGE(PG8_SB(0, 1), b2 + hstep, voffB);
            PG8_WAIT_V(6); PG8_BAR; PG8_MMA(1, 1, At, B1); PG8_BAR;
            PG8_LDB(B0, 1, 0); PG8_SCHED; PG8_LDA(At, 1, 0); PG8_STAGE(PG8_SA(0, 1), a2 + hstep, voffA);
            PG8_WAIT_L(8); PG8_BAR; PG8_WAIT_L(0); PG8_MMA(0, 0, At, B0); PG8_BAR; PG8_SCHED;
            PG8_LDB(B1, 1, 1); PG8_STAGE(PG8_SB(1, 0), b3, voffB);
            PG8_BAR; PG8_WAIT_L(0); PG8_MMA(0, 1, At, B1); PG8_BAR;
            PG8_LDA(At, 1, 1); PG8_STAGE(PG8_SA(1, 0), a3, voffA);
            PG8_BAR; PG8_WAIT_L(0); PG8_MMA(1, 0, At, B0); PG8_BAR; PG8_SCHED;
            PG8_STAGE(PG8_SB(1, 1), b3 + hstep, voffB);
            PG8_WAIT_V(6); PG8_BAR; PG8_MMA(1, 1, At, B1); PG8_BAR;
            }
        }
        if constexpr (ALIGN_EPI) { if (wr == 0) PG8_BAR; }
        if constexpr (!Epi::AFTER_DRAIN) { E(acc, cur, wr, wc, fr, fq); S.done(cur); }
        if (!has_next) break;
#pragma unroll
        for (int a = 0; a < 2; ++a)
#pragma unroll
            for (int b = 0; b < 2; ++b)
#pragma unroll
                for (int m = 0; m < 4; ++m)
#pragma unroll
                    for (int n = 0; n < 2; ++n) acc[a][b][m][n] = (f32x4){0.f, 0.f, 0.f, 0.f};
        cur = nxt; cA = nA; cB = nB; ++ui;
        if constexpr (ALIGN_EPI) { if (wr == 1) PG8_BAR; }
    }
    PG8_WAIT_V(0);
    if constexpr (!ALIGN_EPI) { if (wr == 0) PG8_BAR; }
    PG8_BAR;
    if constexpr (Epi::AFTER_DRAIN) { E.fused(acc, cur, wr, wc, fr, fq, lds, wid, lane); S.done(cur); }
#undef PG8_SA
#undef PG8_SB
#undef PG8_STAGE
#undef PG8_LDA
#undef PG8_LDB
#undef PG8_MMA
#undef PG8_WAIT_V
#undef PG8_WAIT_L
#undef PG8_BAR
#undef PG8_SCHED
}
}
#define LAS __attribute__((address_space(3)))
typedef unsigned short bf16;
typedef short bf16x8 __attribute__((ext_vector_type(8)));
typedef float f32x4 __attribute__((ext_vector_type(4)));
typedef float f32x16 __attribute__((ext_vector_type(16)));
typedef unsigned u32x4 __attribute__((ext_vector_type(4)));
typedef unsigned u32x2 __attribute__((ext_vector_type(2)));

constexpr int DM = 1024, NB = 16, SEQ = 2048, DB = 128, DT = 4;
constexpr int TP = NB * SEQ, TS = DB * DT, MT = TP + TS, M1 = 33536;
constexpr int RW = 1792, QW = 768;
constexpr int R_OFF = 0, W_OFF = 512, K_OFF = 576, V_OFF = 1088, A_OFF = 1600, G_OFF = 1664;
constexpr float RMS_EPS = 1e-6f, GN_EPS = 64e-5f, QSCALE = 0.125f;

constexpr size_t WS_WIN = 0, WS_WOUT = WS_WIN + (size_t)2560 * 1024 * 2, WS_WUP = WS_WOUT + (size_t)1024 * 1024 * 2, WS_WDN = WS_WUP + (size_t)4096 * 1024 * 2,
                 WS_WL = WS_WDN + (size_t)4096 * 1024 * 2, WS_SSQ = WS_WL + (size_t)1536 * 256 * 2, WS_HN = 25165824,
                 WS_QKV = WS_HN + (size_t)M1 * 1024 * 2, WS_P = WS_QKV + (size_t)M1 * QW * 2, WS_L = WS_P + (size_t)M1 * RW * 2, WS_D = WS_L + (size_t)MT * 256 * 2,
                 WS_A = WS_D + (size_t)MT * 512 * 4, WS_G = WS_A + (size_t)MT * 512 * 2, WS_MIX = WS_G + (size_t)MT * 512 * 2, WS_KT = WS_MIX + (size_t)MT * 1024 * 2, WS_G16 = WS_KT + (size_t)TP * 512 * 2, WS_BS = WS_G16 + (size_t)(TP / 16) * 512 * 4, WS_END = WS_BS + (size_t)TP * 8 * 4;
constexpr size_t WS_Y = WS_HN, WS_BON = WS_MIX + 1024, WS_X1G = WS_A, WS_U = WS_HN;
constexpr size_t WS_BAR = WS_SSQ + (size_t)MT * 4;
static_assert(WS_BAR + 3456 * 4 + 256 <= WS_HN, "ws map");
static_assert((size_t)4 * 768 * 2560 * 4 <= (size_t)MT * 512 * 4 && (size_t)4 * 512 * 1024 * 4 <= (size_t)M1 * QW * 2 && (size_t)4 * 512 * 4096 * 4 <= (size_t)MT * 1024 * 2 && (size_t)16 * 512 * 1024 * 4 <= (size_t)MT * 1024 * 2, "split-K scratch");
static_assert(WS_U + (size_t)MT * 4096 * 2 <= WS_A, "U overlay");
static_assert(WS_Y + (size_t)MT * 512 * 4 <= WS_QKV && WS_X1G + (size_t)MT * 1024 * 2 <= WS_MIX, "overlays");

constexpr size_t O_YP = 0, O_YS = O_YP + (size_t)TP * 1024, O_KP = O_YS + (size_t)TS * 1024, O_VP = O_KP + 262144, O_WP = O_VP + 262144, O_SP = O_WP + 524288,
                 O_KS = O_SP + 16384, O_VS = O_KS + 2097152, O_WS = O_VS + 2097152, O_SS = O_WS + 4194304, O_END = O_SS + 131072;

constexpr int LDS_BYTES = 8 * 20224 + 1536 + 16;
constexpr int NTHR = 512;

struct Args { const float* in[26]; float* out; unsigned char* ws; int ph_lo, ph_hi; };

__device__ __forceinline__ float bf2f(unsigned short v) { return __uint_as_float((unsigned)v << 16); }
__device__ __forceinline__ float bflo(unsigned v) { return __uint_as_float(v << 16); }
__device__ __forceinline__ float bfhi(unsigned v) { return __uint_as_float(v & 0xffff0000u); }
typedef float f32x2_t __attribute__((ext_vector_type(2)));
typedef __bf16 bf16x2_t __attribute__((ext_vector_type(2)));
__device__ __forceinline__ unsigned pk2c(float lo, float hi) { const f32x2_t v = {lo, hi}; const bf16x2_t b = __builtin_convertvector(v, bf16x2_t); return __builtin_bit_cast(unsigned, b); }
__device__ __forceinline__ unsigned pk2(float lo, float hi) { return pg8::cvt_pk_bf16(lo, hi); }
__device__ __forceinline__ unsigned pk2n(float lo, float hi) { unsigned r; asm volatile("v_cvt_pk_bf16_f32 %0, %1, %2\n\ts_nop 1" : "=v"(r) : "v"(lo), "v"(hi)); return r; }
__device__ __forceinline__ float wave_sum(float v) {
#pragma unroll
    for (int o = 32; o >= 1; o >>= 1) v += __shfl_xor(v, o);
    return v;
}
__device__ __forceinline__ float wave_max(float v) {
#pragma unroll
    for (int o = 32; o >= 1; o >>= 1) v = fmaxf(v, __shfl_xor(v, o));
    return v;
}
template <int CTRL> __device__ __forceinline__ float dpp_mov(float x) { return __builtin_bit_cast(float, __builtin_amdgcn_update_dpp(0, __builtin_bit_cast(int, x), CTRL, 0xF, 0xF, true)); }
__device__ __forceinline__ float sum16(float x) {
    x += dpp_mov<0xB1>(x);
    x += dpp_mov<0x4E>(x);
    x += dpp_mov<0x124>(x);
    x += dpp_mov<0x128>(x);
    return x;
}

__device__ __forceinline__ void transpose_tile(const float* __restrict__ W, int K, int N, bf16* WT, int kt, int nt, LAS float* scr, int tid) {
#pragma unroll
    for (int i = 0; i < 8; ++i) { const int idx = tid + i * NTHR, kk = idx >> 6, nn = idx & 63; scr[kk * 65 + nn] = W[(size_t)(kt * 64 + kk) * N + nt * 64 + nn]; }
    __syncthreads();
    { const int n = tid >> 3, k8 = (tid & 7) * 8; float v[8];
#pragma unroll
      for (int j = 0; j < 8; ++j) v[j] = scr[(k8 + j) * 65 + n];
      u32x4 w; w.x = pk2(v[0], v[1]); w.y = pk2(v[2], v[3]); w.z = pk2(v[4], v[5]); w.w = pk2(v[6], v[7]);
      *(u32x4*)(WT + (size_t)(nt * 64 + n) * K + kt * 64 + k8) = w; }
    __syncthreads();
}

__device__ __forceinline__ void phase0(const Args& a, LAS unsigned char* lds) {
    const int tid = threadIdx.x, lane = tid & 63, wave = tid >> 6, G = gridDim.x, bx = blockIdx.x;
    unsigned char* ws = a.ws;
    LAS float* scr = (LAS float*)lds;
    {
#define TILE_OF(it_, W_, K_, N_, WT_, kt_, nt_) do { if ((it_) < 640) { W_ = a.in[7]; K_ = 1024; N_ = 2560; WT_ = (bf16*)(ws + WS_WIN); kt_ = (it_) / 40; nt_ = (it_) % 40; } \
        else if ((it_) < 896) { const int j_ = (it_) - 640; W_ = a.in[22]; K_ = 1024; N_ = 1024; WT_ = (bf16*)(ws + WS_WOUT); kt_ = j_ / 16; nt_ = j_ % 16; } \
        else if ((it_) < 1920) { const int j_ = (it_) - 896; W_ = a.in[24]; K_ = 1024; N_ = 4096; WT_ = (bf16*)(ws + WS_WUP); kt_ = j_ / 64; nt_ = j_ % 64; } \
        else { const int j_ = (it_) - 1920; W_ = a.in[25]; K_ = 4096; N_ = 1024; WT_ = (bf16*)(ws + WS_WDN); kt_ = j_ / 16; nt_ = j_ % 16; } } while (0)
        constexpr int NTILE = 640 + 256 + 1024 + 1024;
        float rg[8]; const float* W = nullptr; int K = 0, N = 0, kt = 0, nt = 0; bf16* WT = nullptr;
        int it = bx;
        if (it < NTILE) { TILE_OF(it, W, K, N, WT, kt, nt);
#pragma unroll
            for (int i = 0; i < 8; ++i) { const int idx = tid + i * NTHR; rg[i] = W[(size_t)(kt * 64 + (idx >> 6)) * N + nt * 64 + (idx & 63)]; } }
#pragma unroll 1
        for (; it < NTILE; it += G) {
#pragma unroll
            for (int i = 0; i < 8; ++i) { const int idx = tid + i * NTHR; scr[(idx >> 6) * 65 + (idx & 63)] = rg[i]; }
            __syncthreads();
            bf16* cWT = WT; const int cK = K, ckt = kt, cnt = nt;
            if (it + G < NTILE) { TILE_OF(it + G, W, K, N, WT, kt, nt);
#pragma unroll
                for (int i = 0; i < 8; ++i) { const int idx = tid + i * NTHR; rg[i] = W[(size_t)(kt * 64 + (idx >> 6)) * N + nt * 64 + (idx & 63)]; } }
            { const int n = tid >> 3, k8 = (tid & 7) * 8; float v[8];
#pragma unroll
              for (int j = 0; j < 8; ++j) v[j] = scr[(k8 + j) * 65 + n];
              u32x4 w; w.x = pk2(v[0], v[1]); w.y = pk2(v[2], v[3]); w.z = pk2(v[4], v[5]); w.w = pk2(v[6], v[7]);
              *(u32x4*)(cWT + (size_t)(cnt * 64 + n) * cK + ckt * 64 + k8) = w; }
            __syncthreads();
        }
#undef TILE_OF
    }
    { bf16* WL = (bf16*)(ws + WS_WL); const float* wd = a.in[13]; const float* au = a.in[15]; const float* gu = a.in[16];
      for (int idx = bx * NTHR + tid; idx < 1536 * 256; idx += G * NTHR) { const int n = idx >> 8, k = idx & 255; float v = 0.f;
          if (n < 512) { if (k < 64) v = wd[k * 512 + n]; } else if (n < 1024) { if (k >= 64 && k < 128) v = au[(k - 64) * 512 + (n - 512)]; } else { if (k >= 128) v = gu[(k - 128) * 512 + (n - 1024)]; }
          WL[idx] = (bf16)(pk2(v, 0.f) & 0xffffu); } }
    { float* SSQ = (float*)(ws + WS_SSQ); for (int idx = bx * NTHR + tid; idx < MT; idx += G * NTHR) SSQ[idx] = 0.f; }
    { bf16* HN = (bf16*)(ws + WS_HN); const float* g1 = a.in[6];
      f32x4 gv[4];
#pragma unroll
      for (int i = 0; i < 4; ++i) gv[i] = *(const f32x4*)(g1 + lane * 4 + i * 256);
#pragma unroll 1
      for (int row0_ = (bx * 8 + wave) * 2; row0_ < M1; row0_ += G * 16) {
          f32x4 v[2][4];
#pragma unroll
          for (int u = 0; u < 2; ++u) { const int row = row0_ + u;
              const float* src = row < TP ? a.in[0] + (size_t)row * 1024 : (row < MT ? a.in[1] + (size_t)(row - TP) * 1024 : (row < MT + DB ? a.in[5] + (size_t)(row - MT) * 1024 : nullptr));
#pragma unroll
              for (int i = 0; i < 4; ++i) v[u][i] = src ? *(const f32x4*)(src + lane * 4 + i * 256) : (f32x4){0.f, 0.f, 0.f, 0.f}; }
#pragma unroll
          for (int u = 0; u < 2; ++u) { const int row = row0_ + u; float ss = 0.f;
#pragma unroll
              for (int i = 0; i < 4; ++i) ss += (v[u][i][0] * v[u][i][0] + v[u][i][1] * v[u][i][1]) + (v[u][i][2] * v[u][i][2] + v[u][i][3] * v[u][i][3]);
              if (row < MT) { ss = wave_sum(ss); const float rs = rsqrtf(ss * (1.0f / 1024.0f) + RMS_EPS);
#pragma unroll
                  for (int i = 0; i < 4; ++i) v[u][i] = v[u][i] * rs * gv[i]; }
              float* so = nullptr;
              if (row < TP) { if ((row & (SEQ - 1)) == SEQ - 1) so = a.out + O_SP + (size_t)(row >> 11) * 1024; }
              else if (row < MT) { const int r = row - TP; if ((r & 3) == 3) so = a.out + O_SS + (size_t)(r >> 2) * 1024; }
#pragma unroll
              for (int i = 0; i < 4; ++i) { u32x2 w; w.x = pk2(v[u][i][0], v[u][i][1]); w.y = pk2(v[u][i][2], v[u][i][3]); *(u32x2*)(HN + (size_t)row * 1024 + lane * 4 + i * 256) = w;
                  if (so) *(f32x4*)(so + lane * 4 + i * 256) = v[u][i]; } }
      } }
}

__device__ __forceinline__ int prev_row_of(int row) {
    if (row < TP) return (row & (SEQ - 1)) ? row - 1 : -1;
    const int r = row - TP; return (r & 3) ? row - 1 : MT + (r >> 2);
}
__device__ __forceinline__ void unpack8(const u32x4 w, float* v) { v[0] = bflo(w.x); v[1] = bfhi(w.x); v[2] = bflo(w.y); v[3] = bfhi(w.y); v[4] = bflo(w.z); v[5] = bfhi(w.z); v[6] = bflo(w.w); v[7] = bfhi(w.w); }
__device__ __forceinline__ void phase_lora_in(const Args& a) {
    const bf16* P = (const bf16*)(a.ws + WS_P); bf16* L = (bf16*)(a.ws + WS_L); const float* mu = a.in[11];
    const int nthr = gridDim.x * NTHR;
#pragma unroll 1
    for (int idx0 = blockIdx.x * NTHR + threadIdx.x; idx0 < MT * 32; idx0 += 4 * nthr) {
        u32x4 pw[4], qw[4]; int pcs[4];
#pragma unroll
        for (int u = 0; u < 4; ++u) { const int idx = idx0 + u * nthr; pw[u] = qw[u] = (u32x4){0u, 0u, 0u, 0u}; pcs[u] = 0;
            if (idx < MT * 32) { const int row = idx >> 5, c = (idx & 31) * 8; const int pc = c < 64 ? W_OFF + c : (c < 128 ? A_OFF + (c - 64) : G_OFF + (c - 128)); const int pr = prev_row_of(row);
                pcs[u] = pc; pw[u] = *(const u32x4*)(P + (size_t)row * RW + pc); if (pr >= 0) qw[u] = *(const u32x4*)(P + (size_t)pr * RW + pc); } }
#pragma unroll
        for (int u = 0; u < 4; ++u) { const int idx = idx0 + u * nthr;
            if (idx < MT * 32) { const int row = idx >> 5, c = (idx & 31) * 8, pc = pcs[u];
                float p[8], q[8]; unpack8(pw[u], p); unpack8(qw[u], q);
                const f32x4 m0 = *(const f32x4*)(mu + pc), m1 = *(const f32x4*)(mu + pc + 4);
                float o[8];
#pragma unroll
                for (int j = 0; j < 8; ++j) { const float m = j < 4 ? m0[j] : m1[j - 4]; const float x = p[j] + (q[j] - p[j]) * m;
                    o[j] = c < 64 ? 1.0f - 2.0f * __builtin_amdgcn_rcpf(1.0f + __expf(2.0f * x)) : (c < 128 ? x : __builtin_amdgcn_rcpf(1.0f + __expf(-x))); }
                u32x4 w; w.x = pk2(o[0], o[1]); w.y = pk2(o[2], o[3]); w.z = pk2(o[4], o[5]); w.w = pk2(o[6], o[7]);
                *(u32x4*)(L + (size_t)row * 256 + c) = w; } }
    }
}

constexpr int KROW = 144;
constexpr int VROW = 528;
constexpr int ATT_K = 0, ATT_V = 256 * KROW;
__device__ __forceinline__ int crow(int reg, int h) { return (reg & 3) + 8 * (reg >> 2) + 4 * h; }
#define MFMA32(a, b, c) __builtin_amdgcn_mfma_f32_32x32x16_bf16((a), (b), (c), 0, 0, 0)

__device__ __forceinline__ void attn_prompt_unit(const Args& a, LAS unsigned char* lds, int unit) {
    const int tid = threadIdx.x, lane = tid & 63, wave = tid >> 6;
    const int kvh = unit & 1, n = (unit >> 1) & 15, b = unit >> 5;
    const bf16* QKV = (const bf16*)(a.ws + WS_QKV); bf16* MIX = (bf16*)(a.ws + WS_MIX);
    const float* kg = a.in[9]; const float* qg = a.in[8];
    { const int jj = tid >> 1, hf = tid & 1; const int t = n * 128 - 128 + jj;
      float kx[32], vx[32];
      if (t >= 0) { const bf16* src = QKV + (size_t)(b * SEQ + t) * QW + 512 + kvh * 64 + hf * 32;
#pragma unroll
          for (int i = 0; i < 4; ++i) { unpack8(*(const u32x4*)(src + i * 8), kx + i * 8); unpack8(*(const u32x4*)(src + 128 + i * 8), vx + i * 8); } }
      else {
#pragma unroll
          for (int i = 0; i < 32; ++i) { kx[i] = 0.f; vx[i] = 0.f; } }
      float ss = 0.f;
#pragma unroll
      for (int i = 0; i < 32; ++i) ss += kx[i] * kx[i];
      ss += __shfl_xor(ss, 1);
      const float rs = rsqrtf(ss * (1.0f / 64.0f) + RMS_EPS);
#pragma unroll
      for (int i = 0; i < 32; ++i) kx[i] = kx[i] * rs * kg[hf * 32 + i];
#pragma unroll
      for (int i = 0; i < 4; ++i) { u32x4 w; w.x = pk2(kx[i * 8], kx[i * 8 + 1]); w.y = pk2(kx[i * 8 + 2], kx[i * 8 + 3]); w.z = pk2(kx[i * 8 + 4], kx[i * 8 + 5]); w.w = pk2(kx[i * 8 + 6], kx[i * 8 + 7]);
          *(LAS u32x4*)(lds + ATT_K + jj * KROW + hf * 64 + i * 16) = w; }
#pragma unroll
      for (int i = 0; i < 32; ++i) *(LAS bf16*)(lds + ATT_V + (hf * 32 + i) * VROW + jj * 2) = (bf16)(pk2(vx[i], 0.f) & 0xffffu);
      if (n == 15 && jj >= 128) { float* ko = a.out + O_KP + ((size_t)(b * 128 + jj - 128) * 2 + kvh) * 64 + hf * 32; float* vo = a.out + O_VP + ((size_t)(b * 128 + jj - 128) * 2 + kvh) * 64 + hf * 32;
#pragma unroll
          for (int i = 0; i < 8; ++i) { *(f32x4*)(ko + i * 4) = (f32x4){kx[i * 4], kx[i * 4 + 1], kx[i * 4 + 2], kx[i * 4 + 3]}; *(f32x4*)(vo + i * 4) = (f32x4){vx[i * 4], vx[i * 4 + 1], vx[i * 4 + 2], vx[i * 4 + 3]}; } }
    }
    __syncthreads();
    const int r = lane & 31, h = lane >> 5;
#pragma unroll 1
    for (int it = 0; it < 2; ++it) {
        const int su = wave + 8 * it, g = su >> 2, q0 = (su & 3) * 32, head = kvh * 4 + g;
        const int tok = b * SEQ + n * 128 + q0 + r;
        bf16x8 qb[4];
        { float qx[32]; const bf16* src = QKV + (size_t)tok * QW + head * 64 + 8 * h;
#pragma unroll
          for (int ds = 0; ds < 4; ++ds) unpack8(*(const u32x4*)(src + ds * 16), qx + ds * 8);
          float ss = 0.f;
#pragma unroll
          for (int i = 0; i < 32; ++i) ss += qx[i] * qx[i];
          ss += __shfl_xor(ss, 32);
          const float rs = rsqrtf(ss * (1.0f / 64.0f) + RMS_EPS) * QSCALE;
#pragma unroll
          for (int ds = 0; ds < 4; ++ds) { u32x4 w; const float* gq = qg + ds * 16 + 8 * h; const float* x = qx + ds * 8;
              w.x = pk2n(x[0] * rs * gq[0], x[1] * rs * gq[1]); w.y = pk2n(x[2] * rs * gq[2], x[3] * rs * gq[3]); w.z = pk2n(x[4] * rs * gq[4], x[5] * rs * gq[5]); w.w = pk2n(x[6] * rs * gq[6], x[7] * rs * gq[7]);
              qb[ds] = __builtin_bit_cast(bf16x8, w); } }
        f32x16 x[5];
#pragma unroll
        for (int kt = 0; kt < 5; ++kt) {
#pragma unroll
            for (int i = 0; i < 16; ++i) x[kt][i] = 0.f;
#pragma unroll
            for (int ds = 0; ds < 4; ++ds) { const bf16x8 ka = *(const LAS bf16x8*)(lds + ATT_K + (q0 + kt * 32 + r) * KROW + (ds * 16 + 8 * h) * 2); x[kt] = MFMA32(ka, qb[ds], x[kt]); } }
        const float sink = a.in[10][head];
        float m = sink;
#pragma unroll
        for (int kt = 0; kt < 5; ++kt)
#pragma unroll
            for (int i = 0; i < 16; ++i) { const int jr = kt * 32 + crow(i, h); const int rel = jr - r; const bool ok = rel > 0 && rel <= 128 && (n > 0 || q0 + jr >= 128);
                x[kt][i] = ok ? x[kt][i] : -INFINITY; m = fmaxf(m, x[kt][i]); }
        m = fmaxf(m, __shfl_xor(m, 32));
        float sum = 0.f;
#pragma unroll
        for (int kt = 0; kt < 5; ++kt)
#pragma unroll
            for (int i = 0; i < 16; ++i) { x[kt][i] = __expf(x[kt][i] - m); sum += x[kt][i]; }
        sum += __shfl_xor(sum, 32);
        const float inv = 1.0f / (sum + __expf(sink - m));
        f32x16 y[2];
#pragma unroll
        for (int dt = 0; dt < 2; ++dt)
#pragma unroll
            for (int i = 0; i < 16; ++i) y[dt][i] = 0.f;
#pragma unroll
        for (int kt = 0; kt < 5; ++kt)
#pragma unroll
            for (int s = 0; s < 2; ++s) { u32x4 pw; pw.x = pk2n(x[kt][8 * s], x[kt][8 * s + 1]); pw.y = pk2n(x[kt][8 * s + 2], x[kt][8 * s + 3]); pw.z = pk2n(x[kt][8 * s + 4], x[kt][8 * s + 5]); pw.w = pk2n(x[kt][8 * s + 6], x[kt][8 * s + 7]);
                const bf16x8 ps = __builtin_bit_cast(bf16x8, pw);
#pragma unroll
                for (int dt = 0; dt < 2; ++dt) { const LAS unsigned char* vp = lds + ATT_V + (dt * 32 + r) * VROW + (q0 + kt * 32 + 16 * s + 4 * h) * 2;
                    const u32x2 lo = *(const LAS u32x2*)vp, hi = *(const LAS u32x2*)(vp + 16); u32x4 vw; vw.x = lo.x; vw.y = lo.y; vw.z = hi.x; vw.w = hi.y;
                    y[dt] = MFMA32(__builtin_bit_cast(bf16x8, vw), ps, y[dt]); } }
        bf16* orow = MIX + (size_t)tok * 1024 + head * 64;
#pragma unroll
        for (int dt = 0; dt < 2; ++dt)
#pragma unroll
            for (int gq = 0; gq < 4; ++gq) { u32x2 w; w.x = pk2(y[dt][4 * gq] * inv, y[dt][4 * gq + 1] * inv); w.y = pk2(y[dt][4 * gq + 2] * inv, y[dt][4 * gq + 3] * inv);
                *(u32x2*)(orow + dt * 32 + 8 * gq + 4 * h) = w; }
    }
    __syncthreads();
}

__device__ __forceinline__ void attn_sample_unit(const Args& a, LAS unsigned char* lds, int unit) {
    const int tid = threadIdx.x, lane = tid & 63, wave = tid >> 6;
    const int kvh = unit & 1, b = unit >> 1;
    const bf16* QKV = (const bf16*)(a.ws + WS_QKV); bf16* MIX = (bf16*)(a.ws + WS_MIX);
    constexpr int KS = 68;
    LAS float* Kf = (LAS float*)lds;
    LAS float* Vf = Kf + 132 * KS;
    LAS float* Qf = Vf + 132 * 64;
    LAS float* Pf = Qf + 16 * 64;
    const float* ck = a.in[2]; const float* cv = a.in[3];
    for (int idx = tid; idx < 128 * 16; idx += NTHR) { const int jj = idx >> 4, d = (idx & 15) * 4; const size_t go = ((size_t)(b * 128 + jj) * 2 + kvh) * 64 + d;
        *(LAS f32x4*)(Kf + jj * KS + d) = *(const f32x4*)(ck + go); *(LAS f32x4*)(Vf + jj * 64 + d) = *(const f32x4*)(cv + go); }
    if (wave < 4) { const int t = wave; const bf16* src = QKV + (size_t)(TP + b * 4 + t) * QW + 512 + kvh * 64;
        const float kx = bf2f(src[lane]), vx = bf2f(src[128 + lane]); const float ss = wave_sum(kx * kx);
        Kf[(128 + t) * KS + lane] = kx * rsqrtf(ss * (1.0f / 64.0f) + RMS_EPS) * a.in[9][lane]; Vf[(128 + t) * 64 + lane] = vx; }
#pragma unroll
    for (int i = 0; i < 2; ++i) { const int row = wave * 2 + i, g = row >> 2, t = row & 3; const bf16* src = QKV + (size_t)(TP + b * 4 + t) * QW + (kvh * 4 + g) * 64;
        const float qx = bf2f(src[lane]); const float ss = wave_sum(qx * qx); Qf[row * 64 + lane] = qx * rsqrtf(ss * (1.0f / 64.0f) + RMS_EPS) * a.in[8][lane] * QSCALE; }
    __syncthreads();
    for (int idx = tid; idx < 128 * 16; idx += NTHR) { const int jj = idx >> 4, d = (idx & 15) * 4; const size_t go = ((size_t)(b * 128 + jj) * 2 + kvh) * 64 + d;
        *(f32x4*)(a.out + O_KS + go) = *(const LAS f32x4*)(Kf + (jj + 4) * KS + d); *(f32x4*)(a.out + O_VS + go) = *(const LAS f32x4*)(Vf + (jj + 4) * 64 + d); }
    for (int idx = tid; idx < 16 * 132; idx += NTHR) { const int row = idx / 132, j = idx - row * 132, t = row & 3; float s = -INFINITY;
        if (j > t && j <= t + 128) { f32x4 acc = (f32x4){0.f, 0.f, 0.f, 0.f};
#pragma unroll
            for (int d = 0; d < 64; d += 4) acc = acc + *(const LAS f32x4*)(Qf + row * 64 + d) * *(const LAS f32x4*)(Kf + j * KS + d);
            s = (acc[0] + acc[1]) + (acc[2] + acc[3]); }
        Pf[row * 136 + j] = s; }
    __syncthreads();
#pragma unroll
    for (int i = 0; i < 2; ++i) { const int row = wave * 2 + i, g = row >> 2; const float sink = a.in[10][kvh * 4 + g];
        float s0 = Pf[row * 136 + lane], s1 = Pf[row * 136 + 64 + lane], s2 = lane < 4 ? Pf[row * 136 + 128 + lane] : -INFINITY;
        float m = wave_max(fmaxf(fmaxf(s0, s1), s2)); m = fmaxf(m, sink);
        s0 = __expf(s0 - m); s1 = __expf(s1 - m); s2 = __expf(s2 - m);
        const float inv = 1.0f / (wave_sum(s0 + s1 + s2) + __expf(sink - m));
        Pf[row * 136 + lane] = s0 * inv; Pf[row * 136 + 64 + lane] = s1 * inv; if (lane < 4) Pf[row * 136 + 128 + lane] = s2 * inv; }
    __syncthreads();
    if (tid < 256) { const int row = tid >> 4, d = (tid & 15) * 4, g = row >> 2, t = row & 3; f32x4 o = (f32x4){0.f, 0.f, 0.f, 0.f};
#pragma unroll 4
        for (int j = 0; j < 132; ++j) o = o + *(const LAS f32x4*)(Vf + j * 64 + d) * Pf[row * 136 + j];
        u32x2 w; w.x = pk2(o[0], o[1]); w.y = pk2(o[2], o[3]);
        *(u32x2*)(MIX + (size_t)(TP + b * 4 + t) * 1024 + (kvh * 4 + g) * 64 + d) = w; }
    __syncthreads();
}

constexpr int SC_TOK = 32, SC_BUF = 6 * SC_TOK * 64 * 4;
struct ScanRaw { u32x2 pr, qr, pk, qk, pv, qv, aa; f32x4 dd; };
__device__ __forceinline__ f32x4 unpack4(const u32x2 w) { return (f32x4){bflo(w.x), bfhi(w.x), bflo(w.y), bfhi(w.y)}; }

__device__ __forceinline__ void scan_unit(const Args& a, LAS unsigned char* lds, int row0, int T, int prev0, const float* s_in, float* s_out, int h, int half) {
    const int tid = threadIdx.x, rl = tid >> 4, cl = tid & 15, i = half * 32 + rl, j0 = cl * 4;
    const bf16* P = (const bf16*)(a.ws + WS_P); const bf16* Aa = (const bf16*)(a.ws + WS_A); const float* Dd = (const float*)(a.ws + WS_D);
    float* Y = (float*)(a.ws + WS_Y); bf16* BON = (bf16*)(a.ws + WS_BON);
    const int ch = h * 64 + j0;
    const f32x4 mu_r = *(const f32x4*)(a.in[11] + R_OFF + ch), mu_k = *(const f32x4*)(a.in[11] + K_OFF + ch), mu_v = *(const f32x4*)(a.in[11] + V_OFF + ch);
    const f32x4 kkw = *(const f32x4*)(a.in[17] + ch), kaw = *(const f32x4*)(a.in[18] + ch), rkw = *(const f32x4*)(a.in[19] + ch);
    f32x4 s = s_in ? *(const f32x4*)(s_in + i * 64 + j0) : (f32x4){0.f, 0.f, 0.f, 0.f};
    const int nch = (T + SC_TOK - 1) / SC_TOK;
    const int tt = rl;
    ScanRaw raw;
#define SC_LOAD(c) do { const int t_ = (c) * SC_TOK + tt; if (t_ < T) { const int row_ = row0 + t_; const int pr_ = t_ == 0 ? prev0 : row_ - 1; \
        const bf16* p_ = P + (size_t)row_ * RW + ch; raw.pr = *(const u32x2*)(p_ + R_OFF); raw.pk = *(const u32x2*)(p_ + K_OFF); raw.pv = *(const u32x2*)(p_ + V_OFF); \
        if (pr_ >= 0) { const bf16* q_ = P + (size_t)pr_ * RW + ch; raw.qr = *(const u32x2*)(q_ + R_OFF); raw.qk = *(const u32x2*)(q_ + K_OFF); raw.qv = *(const u32x2*)(q_ + V_OFF); } \
        else { raw.qr = (u32x2){0u, 0u}; raw.qk = (u32x2){0u, 0u}; raw.qv = (u32x2){0u, 0u}; } \
        raw.aa = *(const u32x2*)(Aa + (size_t)row_ * 512 + ch); raw.dd = *(const f32x4*)(Dd + (size_t)row_ * 512 + ch); } } while (0)
#define SC_STAGE(c) do { const int t_ = (c) * SC_TOK + tt; if (t_ < T) { const int row_ = row0 + t_; LAS float* B_ = (LAS float*)(lds + ((c) & 1) * SC_BUF) + tt * 64 + j0; \
        f32x4 xr = unpack4(raw.pr), xk = unpack4(raw.pk), xv = unpack4(raw.pv); f32x4 av_ = unpack4(raw.aa); f32x4 dv_ = raw.dd; \
        _Pragma("unroll") for (int e_ = 0; e_ < 4; ++e_) { av_[e_] = 1.0f / (1.0f + __expf(-av_[e_])); dv_[e_] = __expf(-0.60653066f / (1.0f + __expf(-dv_[e_]))); } \
        xr = xr + (unpack4(raw.qr) - xr) * mu_r; xk = xk + (unpack4(raw.qk) - xk) * mu_k; xv = xv + (unpack4(raw.qv) - xv) * mu_v; \
        f32x4 kk = xk * kkw; float ss_ = sum16((kk[0] * kk[0] + kk[1] * kk[1]) + (kk[2] * kk[2] + kk[3] * kk[3])); \
        kk = kk * (1.0f / fmaxf(sqrtf(ss_), 1e-12f)); \
        const f32x4 kh = xk * (1.0f + (av_ - 1.0f) * kaw); \
        const f32x4 rk_ = xr * kh * rkw; const float bs_ = sum16((rk_[0] + rk_[1]) + (rk_[2] + rk_[3])); \
        if ((cl >> 3) == half) { const f32x4 bo = xv * bs_; u32x2 w_; w_.x = pk2(bo[0], bo[1]); w_.y = pk2(bo[2], bo[3]); *(u32x2*)(BON + (size_t)row_ * 1024 + ch) = w_; } \
        *(LAS f32x4*)(B_) = -kk; *(LAS f32x4*)(B_ + SC_TOK * 64) = kk * av_; *(LAS f32x4*)(B_ + 2 * SC_TOK * 64) = dv_; \
        *(LAS f32x4*)(B_ + 3 * SC_TOK * 64) = kh; *(LAS f32x4*)(B_ + 4 * SC_TOK * 64) = xr; *(LAS f32x4*)(B_ + 5 * SC_TOK * 64) = xv; } } while (0)
    SC_LOAD(0); SC_STAGE(0);
    __syncthreads();
#pragma unroll 1
    for (int c = 0; c < nch; ++c) {
        if (c + 1 < nch) SC_LOAD(c + 1);
        const LAS float* B = (const LAS float*)(lds + (c & 1) * SC_BUF);
        const int nt = min(SC_TOK, T - c * SC_TOK);
        float* yp = Y + (size_t)(row0 + c * SC_TOK) * 512 + h * 64 + i;
        if (nt == SC_TOK) {
            f32x4 a4 = *(const LAS f32x4*)(B + j0), b4 = *(const LAS f32x4*)(B + SC_TOK * 64 + j0), d4 = *(const LAS f32x4*)(B + 2 * SC_TOK * 64 + j0),
                  k4 = *(const LAS f32x4*)(B + 3 * SC_TOK * 64 + j0), r4 = *(const LAS f32x4*)(B + 4 * SC_TOK * 64 + j0);
            float v = B[5 * SC_TOK * 64 + i];
#pragma unroll 1
            for (int tb = 0; tb < SC_TOK; tb += 16) {
                float ykeep = 0.f;
#pragma unroll
                for (int u = 0; u < 16; ++u) {
                    const int tn = (tb + u + 1) & (SC_TOK - 1);
                    const f32x4 na = *(const LAS f32x4*)(B + tn * 64 + j0), nb = *(const LAS f32x4*)(B + SC_TOK * 64 + tn * 64 + j0), nd = *(const LAS f32x4*)(B + 2 * SC_TOK * 64 + tn * 64 + j0),
                                nk = *(const LAS f32x4*)(B + 3 * SC_TOK * 64 + tn * 64 + j0), nr = *(const LAS f32x4*)(B + 4 * SC_TOK * 64 + tn * 64 + j0);
                    const float nv = B[5 * SC_TOK * 64 + tn * 64 + i];
                    const float sa = sum16((s[0] * a4[0] + s[1] * a4[1]) + (s[2] * a4[2] + s[3] * a4[3]));
                    s = s * d4 + b4 * sa + k4 * v;
                    const float y = sum16((s[0] * r4[0] + s[1] * r4[1]) + (s[2] * r4[2] + s[3] * r4[3]));
                    ykeep = (cl == u) ? y : ykeep;
                    a4 = na; b4 = nb; d4 = nd; k4 = nk; r4 = nr; v = nv;
                }
                yp[(size_t)(tb + cl) * 512] = ykeep;
            }
        } else {
#pragma unroll 1
        for (int t = 0; t < nt; ++t) {
            const f32x4 a4 = *(const LAS f32x4*)(B + t * 64 + j0), b4 = *(const LAS f32x4*)(B + SC_TOK * 64 + t * 64 + j0), d4 = *(const LAS f32x4*)(B + 2 * SC_TOK * 64 + t * 64 + j0),
                        k4 = *(const LAS f32x4*)(B + 3 * SC_TOK * 64 + t * 64 + j0), r4 = *(const LAS f32x4*)(B + 4 * SC_TOK * 64 + t * 64 + j0);
            const float v = B[5 * SC_TOK * 64 + t * 64 + i];
            const float sa = sum16((s[0] * a4[0] + s[1] * a4[1]) + (s[2] * a4[2] + s[3] * a4[3]));
            s = s * d4 + b4 * sa + k4 * v;
            const float y = sum16((s[0] * r4[0] + s[1] * r4[1]) + (s[2] * r4[2] + s[3] * r4[3]));
            if (cl == 0) yp[(size_t)t * 512] = y;
        }
        }
        if (c + 1 < nch) SC_STAGE(c + 1);
        __syncthreads();
    }
    *(f32x4*)(s_out + i * 64 + j0) = s;
#undef SC_LOAD
#undef SC_STAGE
}

#define MFMA16(a, b, c) __builtin_amdgcn_mfma_f32_16x16x32_bf16((a), (b), (c), 0, 0, 0)
__device__ __forceinline__ void unpack16(const bf16* p, float* o) { unpack8(*(const u32x4*)p, o); unpack8(*(const u32x4*)(p + 8), o + 8); }
__device__ __forceinline__ u32x4 pack8f(const float* v) { u32x4 w; w.x = pk2c(v[0], v[1]); w.y = pk2c(v[2], v[3]); w.z = pk2c(v[4], v[5]); w.w = pk2c(v[6], v[7]); return w; }

__device__ __forceinline__ void phase_prepass(const Args& a) {
    const int lane = threadIdx.x & 63, gw = blockIdx.x * 8 + (threadIdx.x >> 6), nw = gridDim.x * 8;
    const bf16* P = (const bf16*)(a.ws + WS_P); bf16* Aa = (bf16*)(a.ws + WS_A); float* Dd = (float*)(a.ws + WS_D);
    bf16* KT = (bf16*)(a.ws + WS_KT); float* G16 = (float*)(a.ws + WS_G16); float* BS = (float*)(a.ws + WS_BS);
    const int tt = lane & 15, c0 = (lane >> 4) * 16;
    struct RawQ { u32x4 r0, r1, k0, k1, pr0, pr1, pk0, pk1, a0, a1; f32x4 d0, d1, d2, d3; } cur, nxt;
#define Q_LOAD(q_, it_) do { const int h_ = (it_) & 7, row_ = ((it_) >> 3) * 16 + tt, ch_ = h_ * 64 + c0; const bf16* p_ = P + (size_t)row_ * RW + ch_; \
        q_.r0 = *(const u32x4*)(p_ + R_OFF); q_.r1 = *(const u32x4*)(p_ + R_OFF + 8); q_.k0 = *(const u32x4*)(p_ + K_OFF); q_.k1 = *(const u32x4*)(p_ + K_OFF + 8); \
        if ((row_ & (SEQ - 1)) != 0) { q_.pr0 = *(const u32x4*)(p_ - RW + R_OFF); q_.pr1 = *(const u32x4*)(p_ - RW + R_OFF + 8); q_.pk0 = *(const u32x4*)(p_ - RW + K_OFF); q_.pk1 = *(const u32x4*)(p_ - RW + K_OFF + 8); } \
        else { q_.pr0 = q_.pr1 = q_.pk0 = q_.pk1 = (u32x4){0u, 0u, 0u, 0u}; } \
        const bf16* a_ = Aa + (size_t)row_ * 512 + ch_; q_.a0 = *(const u32x4*)a_; q_.a1 = *(const u32x4*)(a_ + 8); \
        const float* d_ = Dd + (size_t)row_ * 512 + ch_; q_.d0 = *(const f32x4*)d_; q_.d1 = *(const f32x4*)(d_ + 4); q_.d2 = *(const f32x4*)(d_ + 8); q_.d3 = *(const f32x4*)(d_ + 12); } while (0)
    if (gw < (TP / 16) * 8) Q_LOAD(cur, gw);
#pragma unroll 1
    for (int item = gw; item < (TP / 16) * 8; item += nw) {
        const int h = item & 7, cchunk = item >> 3, row = cchunk * 16 + tt, ch = h * 64 + c0;
        if (item + nw < (TP / 16) * 8) Q_LOAD(nxt, item + nw);
        float xr[16], xk[16], aa[16];
        unpack8(cur.r0, xr); unpack8(cur.r1, xr + 8); unpack8(cur.k0, xk); unpack8(cur.k1, xk + 8); unpack8(cur.a0, aa); unpack8(cur.a1, aa + 8);
        { float pr[16]; unpack8(cur.pr0, pr); unpack8(cur.pr1, pr + 8);
#pragma unroll
          for (int g = 0; g < 4; ++g) { const f32x4 m = *(const f32x4*)(a.in[11] + R_OFF + ch + 4 * g);
#pragma unroll
              for (int e = 0; e < 4; ++e) xr[4 * g + e] += (pr[4 * g + e] - xr[4 * g + e]) * m[e]; }
          unpack8(cur.pk0, pr); unpack8(cur.pk1, pr + 8);
#pragma unroll
          for (int g = 0; g < 4; ++g) { const f32x4 m = *(const f32x4*)(a.in[11] + K_OFF + ch + 4 * g);
#pragma unroll
              for (int e = 0; e < 4; ++e) xk[4 * g + e] += (pr[4 * g + e] - xk[4 * g + e]) * m[e]; } }
        const f32x4 dpre[4] = {cur.d0, cur.d1, cur.d2, cur.d3};
        float ss = 0.f, bs = 0.f; float kkv[16], khv[16];
#pragma unroll
        for (int g = 0; g < 4; ++g) { const f32x4 kkw = *(const f32x4*)(a.in[17] + ch + 4 * g), kaw = *(const f32x4*)(a.in[18] + ch + 4 * g), rkw = *(const f32x4*)(a.in[19] + ch + 4 * g);
#pragma unroll
            for (int e4 = 0; e4 < 4; ++e4) { const int e = 4 * g + e4; aa[e] = __builtin_amdgcn_rcpf(1.0f + __expf(-aa[e]));
                kkv[e] = xk[e] * kkw[e4]; ss += kkv[e] * kkv[e];
                khv[e] = xk[e] * (1.0f + (aa[e] - 1.0f) * kaw[e4]); bs += xr[e] * khv[e] * rkw[e4]; } }
        ss += __shfl_xor(ss, 16); ss += __shfl_xor(ss, 32); bs += __shfl_xor(bs, 16); bs += __shfl_xor(bs, 32);
        const float inv = __builtin_amdgcn_rsqf(fmaxf(ss, 1e-24f));
        if (c0 == 0) BS[(size_t)row * 8 + h] = bs;
#pragma unroll
        for (int hf = 0; hf < 2; ++hf) {
            float ld[8], at[8], bt_[8], kt[8], rt[8];
            { const f32x4 d0 = dpre[2 * hf], d1 = dpre[2 * hf + 1];
#pragma unroll
              for (int e8 = 0; e8 < 4; ++e8) { ld[e8] = -0.60653066f * __builtin_amdgcn_rcpf(1.0f + __expf(-d0[e8])); ld[4 + e8] = -0.60653066f * __builtin_amdgcn_rcpf(1.0f + __expf(-d1[e8])); } }
            float gt[8];
#pragma unroll
            for (int e8 = 0; e8 < 8; ++e8) { const int e = hf * 8 + e8;
                float cs = ld[e8];
                cs += dpp_mov<0x111>(cs); cs += dpp_mov<0x112>(cs); cs += dpp_mov<0x114>(cs); cs += dpp_mov<0x118>(cs);
                const float Gt = __expf(cs), Gi = __expf(-cs), Gp = __expf(cs - ld[e8]);
                const float kn = kkv[e] * inv;
                at[e8] = -kn * Gp; bt_[e8] = kn * aa[e] * Gi; kt[e8] = khv[e] * Gi; rt[e8] = xr[e] * Gt; gt[e8] = Gt; }
            { u32x4 w0, w1;
              w0.x = pk2c(at[0], rt[0]); w0.y = pk2c(at[1], rt[1]); w0.z = pk2c(at[2], rt[2]); w0.w = pk2c(at[3], rt[3]); w1.x = pk2c(at[4], rt[4]); w1.y = pk2c(at[5], rt[5]); w1.z = pk2c(at[6], rt[6]); w1.w = pk2c(at[7], rt[7]);
              *(u32x4*)(Dd + (size_t)row * 512 + ch + hf * 8) = w0; *(u32x4*)(Dd + (size_t)row * 512 + ch + hf * 8 + 4) = w1; }
            *(u32x4*)(Aa + (size_t)row * 512 + ch + hf * 8) = pack8f(bt_);
            *(u32x4*)(KT + (size_t)row * 512 + ch + hf * 8) = pack8f(kt);
            if (tt == 15) { *(f32x4*)(G16 + (size_t)cchunk * 512 + ch + hf * 8) = (f32x4){gt[0], gt[1], gt[2], gt[3]}; *(f32x4*)(G16 + (size_t)cchunk * 512 + ch + hf * 8 + 4) = (f32x4){gt[4], gt[5], gt[6], gt[7]}; }
        }
        cur = nxt;
    }
#undef Q_LOAD
}

constexpr int BKT_ROW = 80, VT_ROW = 48;
#define SWZ(row, byteoff) ((((((byteoff) >> 4) ^ ((row) & 7)) << 4) | ((byteoff) & 15)))
constexpr int CH_AT = 0, CH_RT = 2048, CH_BKR = 4096, CH_BKT = 4096 + 4608, CH_VT = CH_BKT + 64 * BKT_ROW, CH_G = CH_VT + 64 * VT_ROW, CH_OPS = CH_G + 256, CH_BYTES = CH_OPS + 3072;
constexpr int SCAN_PAR = 8 * CH_BYTES;
static_assert(SCAN_PAR + 1536 + 16 <= LDS_BYTES, "scan LDS");
__device__ __forceinline__ void scan_mfma_unit(const Args& a, LAS unsigned char* lds, int b, int h) {
    const int tid = threadIdx.x, lane = tid & 63, wave = tid >> 6;
    const bf16* P = (const bf16*)(a.ws + WS_P); const bf16* Aa = (const bf16*)(a.ws + WS_A); const float* Dd = (const float*)(a.ws + WS_D);
    float* Y = (float*)(a.ws + WS_Y); bf16* BON = (bf16*)(a.ws + WS_BON);
    const int row0 = b * SEQ;
    LAS float* PAR = (LAS float*)(lds + SCAN_PAR);
    if (tid < 384) { const int k = tid >> 6, c = tid & 63; const float* src = k == 0 ? a.in[11] + R_OFF : (k == 1 ? a.in[11] + K_OFF : (k == 2 ? a.in[11] + V_OFF : (k == 3 ? a.in[17] : (k == 4 ? a.in[18] : a.in[19])))); PAR[tid] = src[h * 64 + c]; }
    __syncthreads();
    const int n16 = lane & 15, q = lane >> 4;
    f32x4 st[4];
#pragma unroll
    for (int jt = 0; jt < 4; ++jt) st[jt] = (f32x4){0.f, 0.f, 0.f, 0.f};
    const bf16* KT = (const bf16*)(a.ws + WS_KT); const float* G16 = (const float*)(a.ws + WS_G16); const float* BS = (const float*)(a.ws + WS_BS);
    struct RawP { u32x4 d0, d1, d2, d3, b0, b1, k0, k1, v0, v1, pv0, pv1; f32x4 g; float bs; } raw;
    const int tt = lane & 15, c0 = (lane >> 4) * 16, ch = h * 64 + c0;
#define P_LOAD(bi) do { const int t_ = (bi) * 64 + (wave - 4) * 16 + tt; const size_t ro_ = (size_t)(row0 + t_) * 512 + ch; \
        const u32x4* d_ = (const u32x4*)(Dd + ro_); raw.d0 = d_[0]; raw.d1 = d_[1]; raw.d2 = d_[2]; raw.d3 = d_[3]; \
        raw.b0 = *(const u32x4*)(Aa + ro_); raw.b1 = *(const u32x4*)(Aa + ro_ + 8); raw.k0 = *(const u32x4*)(KT + ro_); raw.k1 = *(const u32x4*)(KT + ro_ + 8); \
        const bf16* p_ = P + (size_t)(row0 + t_) * RW + V_OFF + ch; raw.v0 = *(const u32x4*)p_; raw.v1 = *(const u32x4*)(p_ + 8); \
        if (t_ > 0) { raw.pv0 = *(const u32x4*)(p_ - RW); raw.pv1 = *(const u32x4*)(p_ - RW + 8); } else { raw.pv0 = raw.pv1 = (u32x4){0u, 0u, 0u, 0u}; } \
        raw.bs = BS[(size_t)(row0 + t_) * 8 + h]; \
        if (lane < 16) raw.g = *(const f32x4*)(G16 + (size_t)((row0 + (bi) * 64 + (wave - 4) * 16) >> 4) * 512 + h * 64 + 4 * lane); } while (0)
    if (wave >= 4) P_LOAD(0);
#pragma unroll 1
    for (int kb = -1; kb < SEQ / 64; ++kb) {
        if (wave >= 4 && kb + 1 < SEQ / 64) {
        LAS unsigned char* cb = lds + (((kb + 1) & 1) * 4 + (wave - 4)) * CH_BYTES;
        {
            const int t = (kb + 1) * 64 + (wave - 4) * 16 + tt, row = row0 + t;
            { const u32x4 dd[4] = {raw.d0, raw.d1, raw.d2, raw.d3};
              u32x4 aw[2], rw[2];
#pragma unroll
              for (int g = 0; g < 4; ++g) { const unsigned a01 = (dd[g].x & 0xffffu) | (dd[g].y << 16), a23 = (dd[g].z & 0xffffu) | (dd[g].w << 16), r01 = (dd[g].x >> 16) | (dd[g].y & 0xffff0000u), r23 = (dd[g].z >> 16) | (dd[g].w & 0xffff0000u);
                  if (g & 1) { aw[g >> 1].z = a01; aw[g >> 1].w = a23; rw[g >> 1].z = r01; rw[g >> 1].w = r23; } else { aw[g >> 1].x = a01; aw[g >> 1].y = a23; rw[g >> 1].x = r01; rw[g >> 1].y = r23; } }
              *(LAS u32x4*)(cb + CH_AT + tt * 128 + SWZ(tt, c0 * 2)) = aw[0]; *(LAS u32x4*)(cb + CH_AT + tt * 128 + SWZ(tt, c0 * 2 + 16)) = aw[1];
              *(LAS u32x4*)(cb + CH_RT + tt * 128 + SWZ(tt, c0 * 2)) = rw[0]; *(LAS u32x4*)(cb + CH_RT + tt * 128 + SWZ(tt, c0 * 2 + 16)) = rw[1]; }
            *(LAS u32x4*)(cb + CH_BKR + tt * 128 + SWZ(tt, c0 * 2)) = raw.b0; *(LAS u32x4*)(cb + CH_BKR + tt * 128 + SWZ(tt, c0 * 2 + 16)) = raw.b1;
            *(LAS u32x4*)(cb + CH_BKR + (16 + tt) * 128 + SWZ(tt, c0 * 2)) = raw.k0; *(LAS u32x4*)(cb + CH_BKR + (16 + tt) * 128 + SWZ(tt, c0 * 2 + 16)) = raw.k1;
            { const unsigned bw[8] = {raw.b0.x, raw.b0.y, raw.b0.z, raw.b0.w, raw.b1.x, raw.b1.y, raw.b1.z, raw.b1.w}, kw[8] = {raw.k0.x, raw.k0.y, raw.k0.z, raw.k0.w, raw.k1.x, raw.k1.y, raw.k1.z, raw.k1.w};
#pragma unroll
              for (int p = 0; p < 8; ++p) {
                  *(LAS bf16*)(cb + CH_BKT + (c0 + 2 * p) * BKT_ROW + tt * 2) = (bf16)(bw[p] & 0xffffu); *(LAS bf16*)(cb + CH_BKT + (c0 + 2 * p + 1) * BKT_ROW + tt * 2) = (bf16)(bw[p] >> 16);
                  *(LAS bf16*)(cb + CH_BKT + (c0 + 2 * p) * BKT_ROW + (16 + tt) * 2) = (bf16)(kw[p] & 0xffffu); *(LAS bf16*)(cb + CH_BKT + (c0 + 2 * p + 1) * BKT_ROW + (16 + tt) * 2) = (bf16)(kw[p] >> 16); } }
#pragma unroll
            for (int hf = 0; hf < 2; ++hf) { float xv[8], pr[8], bo[8]; unpack8(hf ? raw.v1 : raw.v0, xv); unpack8(hf ? raw.pv1 : raw.pv0, pr);
#pragma unroll
              for (int e = 0; e < 8; ++e) { xv[e] += (pr[e] - xv[e]) * PAR[128 + c0 + hf * 8 + e]; bo[e] = raw.bs * xv[e];
                  *(LAS bf16*)(cb + CH_VT + (c0 + hf * 8 + e) * VT_ROW + tt * 2) = (bf16)(pk2c(xv[e], 0.f) & 0xffffu); }
              *(u32x4*)(BON + (size_t)row * 1024 + ch + hf * 8) = pack8f(bo); }
            if (lane < 16) *(LAS f32x4*)(cb + CH_G + lane * 16) = raw.g;
            if (kb + 2 < SEQ / 64) P_LOAD(kb + 2);
        }
        asm volatile("s_waitcnt lgkmcnt(0)" ::: "memory");
        {
            const int r = lane & 31, hh = lane >> 5;
            f32x16 X;
#pragma unroll
            for (int i = 0; i < 16; ++i) X[i] = 0.f;
#pragma unroll
            for (int ks = 0; ks < 4; ++ks) {
                const bf16x8 ga = *(const LAS bf16x8*)(cb + CH_BKR + r * 128 + SWZ(r, (16 * ks + 8 * hh) * 2));
                const bf16x8 gb = *(const LAS bf16x8*)(cb + (r < 16 ? CH_AT + r * 128 : CH_RT + (r - 16) * 128) + SWZ(r, (16 * ks + 8 * hh) * 2));
                X = MFMA32(ga, gb, X);
            }
            LAS float* XM = (LAS float*)(cb + CH_BKR);
            asm volatile("s_waitcnt lgkmcnt(0)" ::: "memory");
#pragma unroll
            for (int i = 0; i < 16; ++i) { const int rowx = crow(i, hh), s_ = rowx & 15, t_ = r & 15; const bool keep = r < 16 ? (s_ < t_) : (s_ <= t_); XM[rowx * 36 + r] = keep ? X[i] : 0.f; }
            asm volatile("s_waitcnt lgkmcnt(0)" ::: "memory");
        }
        }
        if (wave < 4 && kb >= 0) {
            LAS unsigned char* cb = lds + ((kb & 1) * 4 + wave) * CH_BYTES;
            LAS float* XM = (LAS float*)(cb + CH_BKR);
            const int tcol = lane & 15;
            float x[16];
#pragma unroll
            for (int s_ = 15; s_ >= 0; --s_) {
                float nrow[16];
#pragma unroll
                for (int g = (s_ + 1) >> 2; g < 4; ++g) { const f32x4 v = *(const LAS f32x4*)(XM + s_ * 36 + 4 * g); nrow[4 * g] = v[0]; nrow[4 * g + 1] = v[1]; nrow[4 * g + 2] = v[2]; nrow[4 * g + 3] = v[3]; }
                float acc = 0.f;
#pragma unroll
                for (int s2 = s_ + 1; s2 < 16; ++s2) acc += nrow[s2] * x[s2];
                x[s_] = s_ < tcol ? acc : (s_ == tcol ? 1.0f : 0.f); }
            const int qq = lane >> 4;
            { float o[8];
#pragma unroll
              for (int e = 0; e < 4; ++e) o[e] = qq == 0 ? x[e] : (qq == 1 ? x[4 + e] : (qq == 2 ? x[8 + e] : x[12 + e]));
              o[4] = o[5] = o[6] = o[7] = 0.f;
              *(LAS u32x4*)(cb + CH_OPS + lane * 16) = pack8f(o); }
            { float o[8];
#pragma unroll
              for (int e = 0; e < 8; ++e) o[e] = qq < 2 ? XM[(16 + 8 * qq + e) * 36 + tcol] : 0.f;
              *(LAS u32x4*)(cb + CH_OPS + 1024 + lane * 16) = pack8f(o); }
            { float o[8];
#pragma unroll
              for (int e = 0; e < 4; ++e) { o[e] = XM[(4 * qq + e) * 36 + 16 + tcol]; o[4 + e] = XM[(16 + 4 * qq + e) * 36 + 16 + tcol]; }
              *(LAS u32x4*)(cb + CH_OPS + 2048 + lane * 16) = pack8f(o); }
        }
        __syncthreads();
        if (wave < 4 && kb >= 0) {
            const int icol = wave * 16 + n16;
#pragma unroll 1
            for (int c = 0; c < 4; ++c) {
                const LAS unsigned char* sb = lds + ((kb & 1) * 4 + c) * CH_BYTES;
                u32x2 a0[2], a1[2], r0[2], r1[2], b0[4], b1[4]; f32x4 gs[4];
#pragma unroll
                for (int ks = 0; ks < 2; ++ks) {
                    a0[ks] = *(const LAS u32x2*)(sb + CH_AT + n16 * 128 + SWZ(n16, (32 * ks + 4 * q) * 2)); a1[ks] = *(const LAS u32x2*)(sb + CH_AT + n16 * 128 + SWZ(n16, (32 * ks + 16 + 4 * q) * 2));
                    r0[ks] = *(const LAS u32x2*)(sb + CH_RT + n16 * 128 + SWZ(n16, (32 * ks + 4 * q) * 2)); r1[ks] = *(const LAS u32x2*)(sb + CH_RT + n16 * 128 + SWZ(n16, (32 * ks + 16 + 4 * q) * 2)); }
                u32x4 vw = *(const LAS u32x4*)(sb + CH_VT + icol * VT_ROW + (q & 1) * 16); if (q >= 2) vw = (u32x4){0u, 0u, 0u, 0u};
                const u32x2 v4 = *(const LAS u32x2*)(sb + CH_VT + icol * VT_ROW + 4 * q * 2);
                const bf16x8 nka = *(const LAS bf16x8*)(sb + CH_OPS + 1024 + lane * 16), tm = *(const LAS bf16x8*)(sb + CH_OPS + lane * 16), ny = *(const LAS bf16x8*)(sb + CH_OPS + 2048 + lane * 16);
#pragma unroll
                for (int jt = 0; jt < 4; ++jt) { b0[jt] = *(const LAS u32x2*)(sb + CH_BKT + (16 * jt + n16) * BKT_ROW + 4 * q * 2); b1[jt] = *(const LAS u32x2*)(sb + CH_BKT + (16 * jt + n16) * BKT_ROW + (16 + 4 * q) * 2); }
                bf16x8 sB[2];
#pragma unroll
                for (int ks = 0; ks < 2; ++ks) { u32x4 w; w.x = pk2c(st[2 * ks][0], st[2 * ks][1]); w.y = pk2c(st[2 * ks][2], st[2 * ks][3]); w.z = pk2c(st[2 * ks + 1][0], st[2 * ks + 1][1]); w.w = pk2c(st[2 * ks + 1][2], st[2 * ks + 1][3]); sB[ks] = __builtin_bit_cast(bf16x8, w); }
                f32x4 W = (f32x4){0.f, 0.f, 0.f, 0.f}, Yc = (f32x4){0.f, 0.f, 0.f, 0.f};
                W = MFMA16(nka, __builtin_bit_cast(bf16x8, vw), W);
#pragma unroll
                for (int ks = 0; ks < 2; ++ks) {
                    u32x4 aw; aw.x = a0[ks].x; aw.y = a0[ks].y; aw.z = a1[ks].x; aw.w = a1[ks].y; u32x4 rw; rw.x = r0[ks].x; rw.y = r0[ks].y; rw.z = r1[ks].x; rw.w = r1[ks].y;
                    W = MFMA16(__builtin_bit_cast(bf16x8, aw), sB[ks], W); Yc = MFMA16(__builtin_bit_cast(bf16x8, rw), sB[ks], Yc);
                }
                f32x4 U;
                { u32x4 ww; ww.x = pk2c(W[0], W[1]); ww.y = pk2c(W[2], W[3]); ww.z = 0u; ww.w = 0u;
                  U = MFMA16(tm, __builtin_bit_cast(bf16x8, ww), ((f32x4){0.f, 0.f, 0.f, 0.f})); }
                __builtin_amdgcn_sched_barrier(0);
#pragma unroll
                for (int jt = 0; jt < 4; ++jt) gs[jt] = *(const LAS f32x4*)(sb + CH_G + (16 * jt + 4 * q) * 4);
                bf16x8 uv;
                { u32x4 w; w.x = pk2c(U[0], U[1]); w.y = pk2c(U[2], U[3]); w.z = v4.x; w.w = v4.y; uv = __builtin_bit_cast(bf16x8, w); }
#pragma unroll
                for (int jt = 0; jt < 4; ++jt) {
                    u32x4 bw; bw.x = b0[jt].x; bw.y = b0[jt].y; bw.z = b1[jt].x; bw.w = b1[jt].y;
                    st[jt] = MFMA16(__builtin_bit_cast(bf16x8, bw), uv, st[jt]);
                    st[jt] = st[jt] * gs[jt];
                }
                Yc = MFMA16(ny, uv, Yc);
                float* yp = Y + (size_t)(row0 + kb * 64 + c * 16 + 4 * q) * 512 + h * 64 + icol;
#pragma unroll
                for (int e = 0; e < 4; ++e) yp[(size_t)e * 512] = Yc[e];
            }
        }
        __syncthreads();
    }
    if (wave < 4) { float* so = a.out + O_WP + (size_t)(b * 8 + h) * 4096 + (size_t)(wave * 16 + n16) * 64;
#pragma unroll
        for (int jt = 0; jt < 4; ++jt) *(f32x4*)(so + 16 * jt + 4 * q) = st[jt]; }
}

__device__ __forceinline__ void scan_sample_unit(const Args& a, LAS unsigned char* lds, int b) {
    const int tid = threadIdx.x, lane = tid & 63, wave = tid >> 6;
    const bf16* P = (const bf16*)(a.ws + WS_P); const bf16* Aa = (const bf16*)(a.ws + WS_A); const float* Dd = (const float*)(a.ws + WS_D);
    float* Y = (float*)(a.ws + WS_Y); bf16* BON = (bf16*)(a.ws + WS_BON);
    LAS float* SA = (LAS float*)lds;
    {
        const int tt = tid >> 7, ch = (tid & 127) * 4, row = TP + b * 4 + tt, prow = tt == 0 ? MT + b : row - 1;
        const bf16* p_ = P + (size_t)row * RW + ch; const bf16* q_ = P + (size_t)prow * RW + ch;
        f32x4 xr = unpack4(*(const u32x2*)(p_ + R_OFF)), xk = unpack4(*(const u32x2*)(p_ + K_OFF)), xv = unpack4(*(const u32x2*)(p_ + V_OFF));
        xr = xr + (unpack4(*(const u32x2*)(q_ + R_OFF)) - xr) * *(const f32x4*)(a.in[11] + R_OFF + ch);
        xk = xk + (unpack4(*(const u32x2*)(q_ + K_OFF)) - xk) * *(const f32x4*)(a.in[11] + K_OFF + ch);
        xv = xv + (unpack4(*(const u32x2*)(q_ + V_OFF)) - xv) * *(const f32x4*)(a.in[11] + V_OFF + ch);
        f32x4 av = unpack4(*(const u32x2*)(Aa + (size_t)row * 512 + ch)), dv = *(const f32x4*)(Dd + (size_t)row * 512 + ch);
#pragma unroll
        for (int e = 0; e < 4; ++e) { av[e] = 1.0f / (1.0f + __expf(-av[e])); dv[e] = __expf(-0.60653066f / (1.0f + __expf(-dv[e]))); }
        f32x4 kk = xk * *(const f32x4*)(a.in[17] + ch);
        const float ss = sum16((kk[0] * kk[0] + kk[1] * kk[1]) + (kk[2] * kk[2] + kk[3] * kk[3]));
        kk = kk * (1.0f / fmaxf(sqrtf(ss), 1e-12f));
        const f32x4 kh = xk * (1.0f + (av - 1.0f) * *(const f32x4*)(a.in[18] + ch));
        const f32x4 rk = xr * kh * *(const f32x4*)(a.in[19] + ch);
        const float bs = sum16((rk[0] + rk[1]) + (rk[2] + rk[3]));
        { const f32x4 bo = xv * bs; u32x2 w; w.x = pk2(bo[0], bo[1]); w.y = pk2(bo[2], bo[3]); *(u32x2*)(BON + (size_t)row * 1024 + ch) = w; }
        LAS float* B_ = SA + tt * 512 + ch;
        *(LAS f32x4*)(B_) = -kk; *(LAS f32x4*)(B_ + 2048) = kk * av; *(LAS f32x4*)(B_ + 4096) = dv; *(LAS f32x4*)(B_ + 6144) = kh; *(LAS f32x4*)(B_ + 8192) = xr; *(LAS f32x4*)(B_ + 10240) = xv;
    }
    __syncthreads();
    {
        const int h = wave, i = lane;
        const float* s_in = a.in[4] + (size_t)(b * 8 + h) * 4096 + i * 64; float* s_out = a.out + O_WS + (size_t)(b * 8 + h) * 4096 + i * 64;
        f32x4 s[16];
#pragma unroll
        for (int g = 0; g < 16; ++g) s[g] = *(const f32x4*)(s_in + 4 * g);
#pragma unroll 1
        for (int t = 0; t < DT; ++t) {
            const LAS float* B = SA + t * 512 + h * 64;
            float sa0 = 0.f, sa1 = 0.f;
#pragma unroll
            for (int g = 0; g < 16; g += 2) { const f32x4 a0 = *(const LAS f32x4*)(B + 4 * g), a1 = *(const LAS f32x4*)(B + 4 * g + 4);
                sa0 += (s[g][0] * a0[0] + s[g][1] * a0[1]) + (s[g][2] * a0[2] + s[g][3] * a0[3]); sa1 += (s[g + 1][0] * a1[0] + s[g + 1][1] * a1[1]) + (s[g + 1][2] * a1[2] + s[g + 1][3] * a1[3]); }
            const float sa = sa0 + sa1, v = B[10240 + i];
            float y0 = 0.f, y1 = 0.f;
#pragma unroll
            for (int g = 0; g < 16; ++g) { const f32x4 b4 = *(const LAS f32x4*)(B + 2048 + 4 * g), d4 = *(const LAS f32x4*)(B + 4096 + 4 * g), k4 = *(const LAS f32x4*)(B + 6144 + 4 * g), r4 = *(const LAS f32x4*)(B + 8192 + 4 * g);
                s[g] = s[g] * d4 + b4 * sa + k4 * v;
                const float yy = (s[g][0] * r4[0] + s[g][1] * r4[1]) + (s[g][2] * r4[2] + s[g][3] * r4[3]); if (g & 1) y1 += yy; else y0 += yy; }
            Y[(size_t)(TP + b * 4 + t) * 512 + h * 64 + i] = y0 + y1;
        }
#pragma unroll
        for (int g = 0; g < 16; ++g) *(f32x4*)(s_out + 4 * g) = s[g];
    }
    __syncthreads();
}

__device__ __forceinline__ void phase_post(const Args& a) {
    const float* Y = (const float*)(a.ws + WS_Y); const bf16* BON = (const bf16*)(a.ws + WS_BON); const bf16* Gg = (const bf16*)(a.ws + WS_G); bf16* MIX = (bf16*)(a.ws + WS_MIX);
    for (int idx = blockIdx.x * NTHR + threadIdx.x; idx < MT * 128; idx += gridDim.x * NTHR) {
        const int row = idx >> 7, c = (idx & 127) * 4;
        const f32x4 y = *(const f32x4*)(Y + (size_t)row * 512 + c);
        const float mean = sum16((y[0] + y[1]) + (y[2] + y[3])) * (1.0f / 64.0f);
        const f32x4 dlt = y - mean;
        const float var = sum16((dlt[0] * dlt[0] + dlt[1] * dlt[1]) + (dlt[2] * dlt[2] + dlt[3] * dlt[3])) * (1.0f / 64.0f);
        const f32x4 yn = dlt * rsqrtf(var + GN_EPS) * *(const f32x4*)(a.in[20] + c) + *(const f32x4*)(a.in[21] + c);
        const f32x4 o = (yn + unpack4(*(const u32x2*)(BON + (size_t)row * 1024 + c))) * unpack4(*(const u32x2*)(Gg + (size_t)row * 512 + c));
        u32x2 w; w.x = pk2(o[0], o[1]); w.y = pk2(o[2], o[3]);
        *(u32x2*)(MIX + (size_t)row * 1024 + 512 + c) = w;
    }
}

constexpr int SROWS1 = 768, KSPLIT = 4, KSPLIT4 = 16;
__device__ __forceinline__ void reduce_gemm1(const Args& a) {
    const float* part = (const float*)(a.ws + WS_D); bf16* QKV = (bf16*)(a.ws + WS_QKV); bf16* P = (bf16*)(a.ws + WS_P);
    for (int idx = blockIdx.x * NTHR + threadIdx.x; idx < 640 * 320; idx += gridDim.x * NTHR) {
        const int r = idx / 320, c = (idx - r * 320) * 8;
        f32x4 s0 = (f32x4){0.f, 0.f, 0.f, 0.f}, s1 = s0;
#pragma unroll
        for (int k = 0; k < KSPLIT; ++k) { const float* p = part + ((size_t)k * SROWS1 + r) * 2560 + c; s0 = s0 + *(const f32x4*)p; s1 = s1 + *(const f32x4*)(p + 4); }
        u32x4 w; w.x = pk2(s0[0], s0[1]); w.y = pk2(s0[2], s0[3]); w.z = pk2(s1[0], s1[1]); w.w = pk2(s1[2], s1[3]);
        if (c < 768) *(u32x4*)(QKV + (size_t)(TP + r) * QW + c) = w; else *(u32x4*)(P + (size_t)(TP + r) * RW + (c - 768)) = w;
    }
}
__device__ __forceinline__ void reduce_gemm2(const Args& a) {
    const float* part = (const float*)(a.ws + WS_QKV); bf16* X1G = (bf16*)(a.ws + WS_X1G); float* SSQ = (float*)(a.ws + WS_SSQ);
    const int lane = threadIdx.x & 63;
    for (int r = blockIdx.x * 8 + (threadIdx.x >> 6); r < TS; r += gridDim.x * 8) {
        float ss = 0.f;
#pragma unroll
        for (int i = 0; i < 4; ++i) { const int c = lane * 4 + i * 256;
            f32x4 v = *(const f32x4*)(a.in[1] + (size_t)r * 1024 + c);
#pragma unroll
            for (int k = 0; k < KSPLIT; ++k) v = v + *(const f32x4*)(part + ((size_t)k * TS + r) * 1024 + c);
            *(f32x4*)(a.out + O_YS + (size_t)r * 1024 + c) = v;
            ss += (v[0] * v[0] + v[1] * v[1]) + (v[2] * v[2] + v[3] * v[3]);
            const f32x4 g = *(const f32x4*)(a.in[23] + c); u32x2 w; w.x = pk2(v[0] * g[0], v[1] * g[1]); w.y = pk2(v[2] * g[2], v[3] * g[3]);
            *(u32x2*)(X1G + (size_t)(TP + r) * 1024 + c) = w; }
        ss = wave_sum(ss);
        if (lane == 0) SSQ[TP + r] = ss;
    }
}
__device__ __forceinline__ void reduce_gemm3(const Args& a) {
    const float* part = (const float*)(a.ws + WS_MIX); bf16* U = (bf16*)(a.ws + WS_U); const float* SSQ = (const float*)(a.ws + WS_SSQ);
    for (int idx = blockIdx.x * NTHR + threadIdx.x; idx < TS * 512; idx += gridDim.x * NTHR) {
        const int r = idx >> 9, c = (idx & 511) * 8;
        f32x4 s0 = (f32x4){0.f, 0.f, 0.f, 0.f}, s1 = s0;
#pragma unroll
        for (int k = 0; k < KSPLIT; ++k) { const float* p = part + ((size_t)k * TS + r) * 4096 + c; s0 = s0 + *(const f32x4*)p; s1 = s1 + *(const f32x4*)(p + 4); }
        const float rs = rsqrtf(SSQ[TP + r] * (1.0f / 1024.0f) + RMS_EPS);
#pragma unroll
        for (int e = 0; e < 4; ++e) { const float x = fmaxf(s0[e] * rs, 0.f), y = fmaxf(s1[e] * rs, 0.f); s0[e] = x * x; s1[e] = y * y; }
        u32x4 w; w.x = pk2(s0[0], s0[1]); w.y = pk2(s0[2], s0[3]); w.z = pk2(s1[0], s1[1]); w.w = pk2(s1[2], s1[3]);
        *(u32x4*)(U + (size_t)(TP + r) * 4096 + c) = w;
    }
}
__device__ __forceinline__ void reduce_gemm4(const Args& a) {
    const float* part = (const float*)(a.ws + WS_MIX);
    for (int idx = blockIdx.x * NTHR + threadIdx.x; idx < TS * 256; idx += gridDim.x * NTHR) {
        const int r = idx >> 8, c = (idx & 255) * 4;
        f32x4 v = *(const f32x4*)(a.out + O_YS + (size_t)r * 1024 + c);
#pragma unroll
        for (int k = 0; k < KSPLIT4; ++k) v = v + *(const f32x4*)(part + ((size_t)k * TS + r) * 1024 + c);
        *(f32x4*)(a.out + O_YS + (size_t)r * 1024 + c) = v;
    }
}

constexpr int N_PHASES = 10;
#define XB_TMO      128
#define XB_XCNT(j)  (256  + 64 * (j))
#define XB_XSUB(j)  (1280 + 64 * (j))
#define XB_XGEN(j)  (2304 + 64 * (j))
#define XB_TOP      3328
#define XB_TOPGEN   3392
#define XCD_BAR_WORDS 3456
#define XB_SPIN_CAP (1u << 18)

__device__ __forceinline__ unsigned xb_ld(unsigned* p)              { return __hip_atomic_load(p, __ATOMIC_RELAXED, __HIP_MEMORY_SCOPE_AGENT); }
__device__ __forceinline__ unsigned xb_add(unsigned* p, unsigned v) { return __hip_atomic_fetch_add(p, v, __ATOMIC_RELAXED, __HIP_MEMORY_SCOPE_AGENT); }
__device__ __forceinline__ unsigned xb_xcc_id() { return (unsigned)__builtin_amdgcn_s_getreg((3 << 11) | 20) & 0xFu; }
#define XB_SPIN(cond, bar) do { unsigned _sp = 0; while (cond) { __builtin_amdgcn_s_sleep(1); \
    if ((++_sp & 255u) == 0u) { if (xb_ld(&(bar)[XB_TMO])) break; if (_sp > XB_SPIN_CAP) { atomicAdd(&(bar)[XB_TMO], 1u); break; } } } } while (0)

struct XcdBarrier {
    unsigned* bar; unsigned x;
    volatile LAS unsigned* st;
};

__device__ __forceinline__ XcdBarrier xcd_barrier_post(unsigned* bar, volatile LAS unsigned* st) {
    XcdBarrier b; b.bar = bar; b.x = xb_xcc_id(); b.st = st;
    if (threadIdx.x == 0) (void)xb_add(&bar[XB_XCNT(b.x)], 1u);
    return b;
}
__device__ __forceinline__ void xcd_barrier_complete(unsigned* bar, unsigned x, unsigned& nloc, unsigned& nx) {
    const unsigned G = gridDim.x * gridDim.y * gridDim.z;
    unsigned sum, cnt, mine, sp = 0u;
    for (;;) {
        sum = 0u; cnt = 0u; mine = 0u;
#pragma unroll
        for (unsigned j = 0; j < 16; ++j) { const unsigned c = xb_ld(&bar[XB_XCNT(j)]); sum += c; cnt += (c > 0u) ? 1u : 0u; mine = (j == x) ? c : mine; }
        if (sum == G) break;
        __builtin_amdgcn_s_sleep(1);
        if ((++sp & 255u) == 0u) { if (xb_ld(&bar[XB_TMO])) break; if (sp > XB_SPIN_CAP) { atomicAdd(&bar[XB_TMO], 1u); break; } }
    }
    nloc = mine > 0u ? mine : 1u; nx = cnt > 0u ? cnt : 1u;
}

__device__ __forceinline__ void xcd_barrier(const XcdBarrier& b) {
    asm volatile("s_waitcnt vmcnt(0)" ::: "memory");
    __syncthreads();
    if (threadIdx.x == 0) {
        unsigned* bar = b.bar;
        __builtin_amdgcn_s_waitcnt(0);
        unsigned nloc = b.st[0], nx = b.st[1];
        if (nloc == 0u) { xcd_barrier_complete(bar, b.x, nloc, nx); b.st[0] = nloc; b.st[1] = nx; }
        const unsigned old = xb_add(&bar[XB_XSUB(b.x)], 1u);
        const unsigned gen = old / nloc;
        if (old + 1u == (gen + 1u) * nloc) {
            __builtin_amdgcn_fence(__ATOMIC_RELEASE, "agent");
            asm volatile("s_waitcnt vmcnt(0)" ::: "memory");
            const unsigned og = xb_add(&bar[XB_TOP], 1u);
            const unsigned tg = og / nx;
            if (og + 1u == (tg + 1u) * nx) xb_add(&bar[XB_TOPGEN], 1u);
            else XB_SPIN(xb_ld(&bar[XB_TOPGEN]) == tg, bar);
            __builtin_amdgcn_fence(__ATOMIC_ACQUIRE, "agent");
            xb_add(&bar[XB_XGEN(b.x)], 1u);
            asm volatile("s_waitcnt vmcnt(0)" ::: "memory");
        } else {
            XB_SPIN(xb_ld(&bar[XB_XGEN(b.x)]) == gen, bar);
            __builtin_amdgcn_fence(__ATOMIC_ACQUIRE, "agent");
            asm volatile("s_waitcnt vmcnt(0)" ::: "memory");
        }
    }
    __syncthreads();
}


__device__ __forceinline__ void fast_grid_sync(unsigned* bar, unsigned target) {
    __syncthreads();
    if (threadIdx.x == 0) {
        __builtin_amdgcn_fence(__ATOMIC_RELEASE, "agent");
        __hip_atomic_fetch_add(bar, 1u, __ATOMIC_RELAXED, __HIP_MEMORY_SCOPE_AGENT);
        while (__hip_atomic_load(bar, __ATOMIC_RELAXED, __HIP_MEMORY_SCOPE_AGENT) < target) __builtin_amdgcn_s_sleep(1);
        __builtin_amdgcn_fence(__ATOMIC_ACQUIRE, "agent");
    }
    __syncthreads();
}
__global__ void __launch_bounds__(NTHR, 2) hymba_fwd(Args args) {
    extern __shared__ __attribute__((aligned(16))) unsigned char lds_raw[];
    LAS unsigned char* lds = (LAS unsigned char*)lds_raw;
    cg::grid_group grid = cg::this_grid();
    const int G = gridDim.x, bx = blockIdx.x;
    const int vcu = (G % 8 == 0) ? (bx % 8) * (G / 8) + bx / 8 : bx;
    unsigned char* ws = args.ws;
#ifndef PH_MASK
#define PH_MASK 0x3ff
#endif
#define PHON(k) (((PH_MASK >> (k)) & 1) && lo <= (k) && (k) < hi)
#ifndef PH_TWICE
#define PH_TWICE 0
#endif
#define PHREP(k) for (int rep_ = 0; rep_ < 1 + ((PH_TWICE >> (k)) & 1); ++rep_, (rep_ < 1 + ((PH_TWICE >> (k)) & 1) ? grid.sync() : (void)0))
#define PHSYNC(k) do { if ((k) + 1 < hi && lo <= (k)) { if ((k) == 0) { grid.sync(); xbar = xcd_barrier_post(bar, xst); } else xcd_barrier(xbar); } } while (0)
    const int lo = args.ph_lo, hi = args.ph_hi;
#define INBAR() do { if (hi - lo > 1) xcd_barrier(xbar); } while (0)
    unsigned* bar = (unsigned*)(ws + WS_BAR); unsigned nbar = 0u;
    if (lo == 0 && bx == 0) for (int w_ = threadIdx.x; w_ < XCD_BAR_WORDS; w_ += NTHR) __hip_atomic_store(bar + w_, 0u, __ATOMIC_RELAXED, __HIP_MEMORY_SCOPE_AGENT);
    volatile LAS unsigned* xst = (volatile LAS unsigned*)(lds + LDS_BYTES - 16);
    if (threadIdx.x < 2) xst[threadIdx.x] = 0u;
    __syncthreads();
    XcdBarrier xbar; xbar.bar = bar; xbar.x = 0; xbar.st = xst;
    if (PHON(0)) PHREP(0) phase0(args, lds);
    PHSYNC(0);
    if (PHON(1)) PHREP(1) { { pg8::Gemm g{(const pg8::bf16_t*)(ws + WS_HN), (const pg8::bf16_t*)(ws + WS_WIN), TP, 2560, 1024, 1024}; pg8::StaticOrder S; S.init(g.M, g.N, G, bx);
          pg8::EpiProj E{(pg8::bf16_t*)(ws + WS_QKV), (pg8::bf16_t*)(ws + WS_P)}; pg8::gemm_phase<pg8::EpiProj, pg8::StaticOrder, true, true>(lds, g, S, E); }
        { pg8::Gemm g{(const pg8::bf16_t*)(ws + WS_HN) + (size_t)TP * 1024, (const pg8::bf16_t*)(ws + WS_WIN), SROWS1, 2560, 1024, 1024 / KSPLIT}; pg8::SplitKOrder S; S.init(g.M, g.N, g.K, g.kloop, G, bx);
          pg8::EpiPartial E{(float*)(ws + WS_D), SROWS1, 2560, g.kloop * 2}; pg8::gemm_phase<pg8::EpiPartial, pg8::SplitKOrder, true, true>(lds, g, S, E); }
        INBAR(); reduce_gemm1(args); }
    PHSYNC(1);
    if (PHON(2)) PHREP(2) { phase_lora_in(args); }
    PHSYNC(2);
    if (PHON(3)) PHREP(3) { pg8::Gemm g{(const pg8::bf16_t*)(ws + WS_L), (const pg8::bf16_t*)(ws + WS_WL), MT, 1536, 256, 256}; pg8::StaticOrder S; S.init(g.M, g.N, G, bx);
        pg8::EpiLora E{(float*)(ws + WS_D), (pg8::bf16_t*)(ws + WS_A), (pg8::bf16_t*)(ws + WS_G), args.in[12], args.in[14]}; pg8::gemm_phase<pg8::EpiLora, pg8::StaticOrder, true, true>(lds, g, S, E); }
    PHSYNC(3);
    if (PHON(4)) PHREP(4) phase_prepass(args);
    PHSYNC(4);
    if (PHON(5)) PHREP(5) {
#ifndef PROBE_PROMPT2
#define PROBE_PROMPT2 1
#endif
        for (int u = bx; u < 128; u += G) scan_mfma_unit(args, lds, u >> 3, u & 7);
        { const int nb = G > 128 ? G - 128 : G, sb = G > 128 ? bx - 128 : bx;
          if (sb >= 0) { for (int u = sb; u < DB; u += nb) scan_sample_unit(args, lds, u);
              for (int u = sb; u < 512; u += nb) attn_prompt_unit(args, lds, u);
              for (int u = sb; u < 256; u += nb) attn_sample_unit(args, lds, u); } } }
    PHSYNC(5);
    if (PHON(6)) PHREP(6) phase_post(args);
    PHSYNC(6);
    if (PHON(7)) PHREP(7) { { pg8::Gemm g{(const pg8::bf16_t*)(ws + WS_MIX), (const pg8::bf16_t*)(ws + WS_WOUT), TP, 1024, 1024, 1024}; pg8::StaticOrder S; S.init(g.M, g.N, G, bx);
          pg8::EpiOut E{args.in[0], args.in[1], TP, args.out, (pg8::bf16_t*)(ws + WS_X1G), args.in[23], (float*)(ws + WS_SSQ)}; pg8::gemm_phase<pg8::EpiOut, pg8::StaticOrder, true, true>(lds, g, S, E); }
        { pg8::Gemm g{(const pg8::bf16_t*)(ws + WS_MIX) + (size_t)TP * 1024, (const pg8::bf16_t*)(ws + WS_WOUT), TS, 1024, 1024, 1024 / KSPLIT}; pg8::SplitKOrder S; S.init(g.M, g.N, g.K, g.kloop, G, bx);
          pg8::EpiPartial E{(float*)(ws + WS_QKV), TS, 1024, g.kloop * 2}; pg8::gemm_phase<pg8::EpiPartial, pg8::SplitKOrder, true, true>(lds, g, S, E); }
        INBAR(); reduce_gemm2(args); }
    PHSYNC(7);
    if (PHON(8)) PHREP(8) { { pg8::Gemm g{(const pg8::bf16_t*)(ws + WS_X1G), (const pg8::bf16_t*)(ws + WS_WUP), TP, 4096, 1024, 1024}; pg8::StaticOrder S; S.init(g.M, g.N, G, bx);
          pg8::EpiUp E{(pg8::bf16_t*)(ws + WS_U), (const float*)(ws + WS_SSQ)}; pg8::gemm_phase<pg8::EpiUp, pg8::StaticOrder, true, true>(lds, g, S, E); }
        { pg8::Gemm g{(const pg8::bf16_t*)(ws + WS_X1G) + (size_t)TP * 1024, (const pg8::bf16_t*)(ws + WS_WUP), TS, 4096, 1024, 1024 / KSPLIT}; pg8::SplitKOrder S; S.init(g.M, g.N, g.K, g.kloop, G, bx);
          pg8::EpiPartial E{(float*)(ws + WS_MIX), TS, 4096, g.kloop * 2}; pg8::gemm_phase<pg8::EpiPartial, pg8::SplitKOrder, true, true>(lds, g, S, E); }
        INBAR(); reduce_gemm3(args); }
    PHSYNC(8);
    if (PHON(9)) PHREP(9) { { pg8::Gemm g{(const pg8::bf16_t*)(ws + WS_U), (const pg8::bf16_t*)(ws + WS_WDN), TP, 1024, 4096, 4096}; pg8::StaticOrder S; S.init(g.M, g.N, G, bx);
          pg8::EpiDown E{args.out}; pg8::gemm_phase<pg8::EpiDown, pg8::StaticOrder, true, true>(lds, g, S, E); }
        { pg8::Gemm g{(const pg8::bf16_t*)(ws + WS_U) + (size_t)TP * 4096, (const pg8::bf16_t*)(ws + WS_WDN), TS, 1024, 4096, 4096 / KSPLIT4}; pg8::SplitKOrder S; S.init(g.M, g.N, g.K, g.kloop, G, bx);
          pg8::EpiPartial E{(float*)(ws + WS_MIX), TS, 1024, g.kloop * 2}; pg8::gemm_phase<pg8::EpiPartial, pg8::SplitKOrder, true, true>(lds, g, S, E); }
        INBAR(); reduce_gemm4(args); }
    (void)vcu;
}

#ifndef MK_PER_PHASE
#define MK_PER_PHASE 0
#endif
extern "C" void kernel_launch(void* const* d_in, const int* in_sizes, int n_in, void* d_out, int out_size, void* d_ws, size_t ws_size, hipStream_t stream) {
    static int grid = 0;
    if (grid == 0) {
        if (n_in != 26 || (size_t)out_size != O_END || ws_size < WS_END) { fprintf(stderr, "kernel_launch: unexpected sizes n_in %d out %d ws %zu (need %zu)\n", n_in, out_size, ws_size, (size_t)WS_END); grid = -1; return; }
        int dev = 0, cus = 0, per_cu = 0;
        hipGetDevice(&dev); hipDeviceGetAttribute(&cus, hipDeviceAttributeMultiprocessorCount, dev);
        if (hipFuncSetAttribute((const void*)hymba_fwd, hipFuncAttributeMaxDynamicSharedMemorySize, LDS_BYTES) != hipSuccess) { fprintf(stderr, "kernel_launch: hipFuncSetAttribute failed\n"); grid = -1; return; }
        if (hipOccupancyMaxActiveBlocksPerMultiprocessor(&per_cu, (const void*)hymba_fwd, NTHR, LDS_BYTES) != hipSuccess || per_cu < 1) { fprintf(stderr, "kernel_launch: occupancy query failed (%d)\n", per_cu); per_cu = 1; }
        (void)hipGetLastError();
        grid = cus * (per_cu > 1 ? 1 : per_cu);
        fprintf(stderr, "kernel_launch: cus %d per_cu %d grid %d\n", cus, per_cu, grid);
    }
    if (grid < 0) return;
    Args a{};
    for (int i = 0; i < 26; ++i) a.in[i] = (const float*)d_in[i];
    a.out = (float*)d_out; a.ws = (unsigned char*)d_ws;
#if MK_PER_PHASE
    for (int ph = 0; ph < N_PHASES; ++ph) { a.ph_lo = ph; a.ph_hi = ph + 1; hipLaunchKernelGGL(hymba_fwd, dim3(grid), dim3(NTHR), LDS_BYTES, stream, a); }
#else
    a.ph_lo = 0; a.ph_hi = N_PHASES;
    void* kargs[] = {&a};
    hipError_t e = hipLaunchCooperativeKernel((const void*)hymba_fwd, dim3(grid), dim3(NTHR), kargs, LDS_BYTES, stream);
    if (e != hipSuccess) fprintf(stderr, "kernel_launch: cooperative launch failed: %s (grid %d)\n", hipGetErrorString(e), grid);
#endif
}
```
